# Optimizing an MI355X kernel written in HIP

```python
import jax, jax.numpy as jnp
from jax import lax
import numpy as np

D_MODEL = 1024
BATCH = 2
SEQ = 8192
DEPTH = 2

POOL_WIDTH = 256
POOL_GROUPS = 4
POOL_WINDOWS = (2, 4, 8, 16)
CONV_WIDTH = 256
CONV_KERNEL = 31
HEAD_DIM = 64
N_Q_HEADS = 8
N_KV_HEADS = 2
Q_PER_KV = N_Q_HEADS // N_KV_HEADS
ATTN_WIDTH = N_Q_HEADS * HEAD_DIM
KV_WIDTH = N_KV_HEADS * HEAD_DIM
WINDOW = 128
BLOCK = 128
D_MIX = POOL_WIDTH + CONV_WIDTH + ATTN_WIDTH
D_IN = 2 * POOL_WIDTH + 3 * CONV_WIDTH + 2 * ATTN_WIDTH + 2 * KV_WIDTH
EPS = 1e-6

kernel_name = "hybrid_pool_conv_swa_block"


def rms_norm(x, g):
    xf = x.astype(jnp.float32)
    y = xf * lax.rsqrt(jnp.mean(xf * xf, axis=-1, keepdims=True) + EPS)
    return (y * g.astype(jnp.float32)).astype(x.dtype)


def layer_norm(x, g, b):
    xf = x.astype(jnp.float32)
    mu = jnp.mean(xf, axis=-1, keepdims=True)
    var = jnp.mean(jnp.square(xf - mu), axis=-1, keepdims=True)
    y = (xf - mu) * lax.rsqrt(var + EPS)
    return (y * g.astype(jnp.float32) + b.astype(jnp.float32)).astype(x.dtype)


def alibi_slopes():
    return jnp.asarray([2.0 ** (-8.0 * (h + 1) / N_Q_HEADS) for h in range(N_Q_HEADS)], dtype=jnp.float32)


def pool_mixer(u, w, scale):
    B, S, _ = u.shape
    gw = POOL_WIDTH // POOL_GROUPS
    uf = u.astype(jnp.float32)
    c = jnp.cumsum(uf, axis=1)
    t = jnp.arange(S, dtype=jnp.float32)[:, None]
    outs = []
    for g, wnd in enumerate(POOL_WINDOWS):
        cg = c[..., g * gw:(g + 1) * gw]
        prev = jnp.pad(cg, ((0, 0), (wnd, 0), (0, 0)))[:, :S]
        cnt = jnp.minimum(t + 1.0, float(wnd))
        outs.append((cg - prev) / cnt)
    pooled = jnp.stack(outs, axis=2)
    diff = (pooled - uf.reshape(B, S, POOL_GROUPS, gw)).astype(u.dtype)
    y = jnp.einsum('bsgc,gcd->bsgd', diff, w).reshape(B, S, POOL_WIDTH)
    return y * scale


def conv_module(a, b, dw, dw_bias, ln_g, ln_b, pw):
    h = a * jax.nn.sigmoid(b)
    h = jnp.pad(h, ((0, 0), (CONV_KERNEL - 1, 0), (0, 0)))
    h = lax.conv_general_dilated(h, dw[:, None, :], window_strides=(1,), padding='VALID',
                                 dimension_numbers=('NWC', 'WIO', 'NWC'),
                                 feature_group_count=CONV_WIDTH) + dw_bias
    h = layer_norm(h, ln_g, ln_b)
    h = jax.nn.silu(h)
    return jnp.einsum('bsc,cd->bsd', h, pw)


def sliding_window_attention(q, k, v, sinks):
    B, S, _ = q.shape
    nb = S // BLOCK
    qb = q.reshape(B, nb, BLOCK, N_KV_HEADS, Q_PER_KV, HEAD_DIM) * (HEAD_DIM ** -0.5)
    kr = jnp.pad(k.reshape(B, nb, BLOCK, N_KV_HEADS, HEAD_DIM), ((0, 0), (1, 0), (0, 0), (0, 0), (0, 0)))
    vr = jnp.pad(v.reshape(B, nb, BLOCK, N_KV_HEADS, HEAD_DIM), ((0, 0), (1, 0), (0, 0), (0, 0), (0, 0)))
    kb = jnp.concatenate([kr[:, :-1], kr[:, 1:]], axis=2)
    vb = jnp.concatenate([vr[:, :-1], vr[:, 1:]], axis=2)
    scores = jnp.einsum('bnqkgd,bnskd->bnkgqs', qb, kb).astype(jnp.float32)
    i = jnp.arange(BLOCK)[:, None]
    j = jnp.arange(2 * BLOCK)[None, :]
    dist = BLOCK + i - j
    in_band = (dist >= 0) & (dist < WINDOW)
    key_exists = ~(((jnp.arange(nb) == 0)[:, None, None]) & (j < BLOCK)[None])
    valid = in_band[None] & key_exists
    bias = -alibi_slopes().reshape(N_KV_HEADS, Q_PER_KV)[:, :, None, None] * dist.astype(jnp.float32)
    scores = jnp.where(valid[None, :, None, None], scores + bias[None, None], -1e30)
    sink = jnp.broadcast_to(sinks.astype(jnp.float32).reshape(N_KV_HEADS, Q_PER_KV)[None, None, :, :, None, None],
                            scores.shape[:-1] + (1,))
    p = jax.nn.softmax(jnp.concatenate([scores, sink], axis=-1), axis=-1)[..., :-1]
    out = jnp.einsum('bnkgqs,bnskd->bnqkgd', p.astype(v.dtype), vb)
    return out.reshape(B, S, ATTN_WIDTH)


def split_columns(proj):
    sizes = (POOL_WIDTH, POOL_WIDTH, CONV_WIDTH, CONV_WIDTH, CONV_WIDTH,
             ATTN_WIDTH, KV_WIDTH, KV_WIDTH, ATTN_WIDTH)
    idx = [int(s) for s in np.cumsum(sizes)[:-1]]
    return jnp.split(proj, idx, axis=-1)


def setup_inputs(seed: int = 0) -> dict:
    key = jax.random.key(seed)
    ks = jax.random.split(key, 14)
    f32 = jnp.float32
    gw = POOL_WIDTH // POOL_GROUPS
    x = jax.random.normal(ks[0], (BATCH, SEQ, D_MODEL), f32)
    ln_g = 1.0 + 0.05 * jax.random.normal(ks[1], (DEPTH, D_MODEL), f32)
    w_in = jax.random.normal(ks[2], (DEPTH, D_MODEL, D_IN), f32) * D_MODEL ** -0.5
    pool_w = jax.random.normal(ks[3], (DEPTH, POOL_GROUPS, gw, gw), f32) * gw ** -0.5
    pool_scale = 0.5 + 0.05 * jax.random.normal(ks[4], (DEPTH, POOL_WIDTH), f32)
    conv_dw = jax.random.normal(ks[5], (DEPTH, CONV_KERNEL, CONV_WIDTH), f32) * CONV_KERNEL ** -0.5
    conv_b = 0.02 * jax.random.normal(ks[6], (DEPTH, CONV_WIDTH), f32)
    conv_ln_g = 1.0 + 0.05 * jax.random.normal(ks[7], (DEPTH, CONV_WIDTH), f32)
    conv_ln_b = 0.02 * jax.random.normal(ks[8], (DEPTH, CONV_WIDTH), f32)
    conv_pw = jax.random.normal(ks[9], (DEPTH, CONV_WIDTH, CONV_WIDTH), f32) * CONV_WIDTH ** -0.5
    attn_sinks = 0.5 * jax.random.normal(ks[10], (DEPTH, N_Q_HEADS), f32)
    w_out = jax.random.normal(ks[11], (DEPTH, D_MIX, D_MODEL), f32) * D_MIX ** -0.5
    final_g = 1.0 + 0.05 * jax.random.normal(ks[12], (D_MODEL,), f32)
    return {"x": x, "ln_g": ln_g, "w_in": w_in, "pool_w": pool_w, "pool_scale": pool_scale,
            "conv_dw": conv_dw, "conv_b": conv_b, "conv_ln_g": conv_ln_g, "conv_ln_b": conv_ln_b,
            "conv_pw": conv_pw, "attn_sinks": attn_sinks, "w_out": w_out, "final_g": final_g}


def reference(x, ln_g, w_in, pool_w, pool_scale, conv_dw, conv_b, conv_ln_g, conv_ln_b,
              conv_pw, attn_sinks, w_out, final_g):
    for l in range(DEPTH):
        h = rms_norm(x, ln_g[l])
        proj = jnp.einsum('bsd,de->bse', h, w_in[l])
        (u_pool, g_pool, c_a, c_b, g_conv, q, k, v, g_attn) = split_columns(proj)
        y_pool = pool_mixer(u_pool, pool_w[l], pool_scale[l])
        y_conv = conv_module(c_a, c_b, conv_dw[l], conv_b[l], conv_ln_g[l], conv_ln_b[l], conv_pw[l])
        y_attn = sliding_window_attention(q, k, v, attn_sinks[l])
        y = jnp.concatenate([y_pool * jax.nn.silu(g_pool),
                             y_conv * jax.nn.silu(g_conv),
                             y_attn * jax.nn.silu(g_attn)], axis=-1)
        x = x + jnp.einsum('bse,ed->bsd', y, w_out[l])
    return rms_norm(x, final_g)
```

```cpp
#include <hip/hip_runtime.h>
#include <cstdio>
#include <cstdint>

constexpr int D_MODEL = 1024, BATCH = 2, SEQ = 8192, DEPTH = 2, M_TOK = BATCH * SEQ;
constexpr int D_IN = 2560, D_MIX = 1024;
constexpr int C_UPOOL = 0, C_GPOOL = 256, C_CA = 512, C_CB = 768, C_GCONV = 1024, C_Q = 1280, C_K = 1792, C_V = 1920, C_GATTN = 2048;
constexpr float EPS = 1e-6f;

__device__ __forceinline__ float wave_sum(float v) {
#pragma unroll
    for (int o = 1; o < 64; o <<= 1) v += __shfl_xor(v, o);
    return v;
}
__device__ __forceinline__ float silu_f(float x) { return x / (1.f + __expf(-x)); }
__device__ __forceinline__ float sigmoid_f(float x) { return 1.f / (1.f + __expf(-x)); }

__global__ void __launch_bounds__(256) k_rmsnorm(const float* x, const float* g, float* out) {
    const int row = blockIdx.x * 4 + (threadIdx.x >> 6), lane = threadIdx.x & 63;
    const float4* xr = (const float4*)(x + (size_t)row * D_MODEL);
    float4 v[4]; float s = 0.f;
#pragma unroll
    for (int j = 0; j < 4; ++j) { v[j] = xr[lane + 64 * j]; s += v[j].x * v[j].x + v[j].y * v[j].y + v[j].z * v[j].z + v[j].w * v[j].w; }
    s = wave_sum(s);
    const float r = rsqrtf(s * (1.f / D_MODEL) + EPS);
    float4* o = (float4*)(out + (size_t)row * D_MODEL);
#pragma unroll
    for (int j = 0; j < 4; ++j) { const float4 gg = ((const float4*)g)[lane + 64 * j]; float4 w; w.x = v[j].x * r * gg.x; w.y = v[j].y * r * gg.y; w.z = v[j].z * r * gg.z; w.w = v[j].w * r * gg.w; o[lane + 64 * j] = w; }
}

__global__ void __launch_bounds__(256) k_gemm(const float* A, const float* B, float* C, const float* R, int M, int N, int K) {
    __shared__ float sA[16][64 + 4];
    __shared__ float sB[16][64 + 4];
    const int tx = threadIdx.x & 15, ty = threadIdx.x >> 4;
    const int m0 = blockIdx.y * 64, n0 = blockIdx.x * 64;
    float acc[4][4] = {};
    for (int k0 = 0; k0 < K; k0 += 16) {
        for (int e = threadIdx.x; e < 64 * 16; e += 256) { const int r = e >> 4, c = e & 15; sA[c][r] = A[(size_t)(m0 + r) * K + k0 + c]; }
        for (int e = threadIdx.x; e < 16 * 64; e += 256) { const int r = e >> 6, c = e & 63; sB[r][c] = B[(size_t)(k0 + r) * N + n0 + c]; }
        __syncthreads();
#pragma unroll
        for (int kk = 0; kk < 16; ++kk) {
            float a[4], b[4];
#pragma unroll
            for (int i = 0; i < 4; ++i) { a[i] = sA[kk][ty * 4 + i]; b[i] = sB[kk][tx * 4 + i]; }
#pragma unroll
            for (int i = 0; i < 4; ++i)
#pragma unroll
                for (int j = 0; j < 4; ++j) acc[i][j] += a[i] * b[j];
        }
        __syncthreads();
    }
#pragma unroll
    for (int i = 0; i < 4; ++i)
#pragma unroll
        for (int j = 0; j < 4; ++j) { const size_t o = (size_t)(m0 + ty * 4 + i) * N + n0 + tx * 4 + j; C[o] = (R ? R[o] : 0.f) + acc[i][j]; }
}

__global__ void __launch_bounds__(256) k_pool_diff(const float* proj, float* diff) {
    const int tok = blockIdx.x, c = threadIdx.x, t = tok % SEQ, g = c >> 6, wnd = 2 << g;
    const int n = (t + 1 < wnd) ? t + 1 : wnd;
    float s = 0.f;
    for (int j = 0; j < n; ++j) s += proj[(size_t)(tok - j) * D_IN + C_UPOOL + c];
    diff[(size_t)tok * 256 + c] = s / (float)n - proj[(size_t)tok * D_IN + C_UPOOL + c];
}
__global__ void __launch_bounds__(256) k_pool_out(const float* proj, const float* diff, const float* w, const float* scale, float* Y) {
    const int tok = blockIdx.x, d = threadIdx.x, g = d >> 6, dd = d & 63;
    float s = 0.f;
    for (int c = 0; c < 64; ++c) s += diff[(size_t)tok * 256 + g * 64 + c] * w[(g * 64 + c) * 64 + dd];
    s *= scale[d];
    Y[(size_t)tok * D_MIX + d] = s * silu_f(proj[(size_t)tok * D_IN + C_GPOOL + d]);
}
__global__ void __launch_bounds__(256) k_conv(const float* proj, const float* dw, const float* dwb, const float* lg, const float* lb, float* hn) {
    __shared__ float red[8];
    const int tok = blockIdx.x, c = threadIdx.x, t = tok % SEQ;
    float s = dwb[c];
    for (int j = 0; j < 31; ++j) { const int dt = 30 - j; if (t - dt >= 0) { const size_t o = (size_t)(tok - dt) * D_IN; s += proj[o + C_CA + c] * sigmoid_f(proj[o + C_CB + c]) * dw[j * 256 + c]; } }
    float ws = wave_sum(s);
    if ((c & 63) == 0) red[c >> 6] = ws;
    __syncthreads();
    const float mu = (red[0] + red[1] + red[2] + red[3]) * (1.f / 256.f);
    const float dlt = s - mu;
    float wq = wave_sum(dlt * dlt);
    if ((c & 63) == 0) red[4 + (c >> 6)] = wq;
    __syncthreads();
    const float var = (red[4] + red[5] + red[6] + red[7]) * (1.f / 256.f);
    const float y = dlt * rsqrtf(var + EPS) * lg[c] + lb[c];
    hn[(size_t)tok * 256 + c] = silu_f(y);
}
__global__ void __launch_bounds__(256) k_conv_pw(const float* proj, const float* hn, const float* pw, float* Y) {
    __shared__ float sh[256];
    const int tok = blockIdx.x, d = threadIdx.x;
    sh[d] = hn[(size_t)tok * 256 + d];
    __syncthreads();
    float s = 0.f;
    for (int c = 0; c < 256; ++c) s += sh[c] * pw[c * 256 + d];
    Y[(size_t)tok * D_MIX + 256 + d] = s * silu_f(proj[(size_t)tok * D_IN + C_GCONV + d]);
}
__global__ void __launch_bounds__(512) k_attn(const float* proj, const float* sinks, float* Y) {
    const int tok = blockIdx.x, h = threadIdx.x >> 6, lane = threadIdx.x & 63, t = tok % SEQ, kvh = h >> 2;
    const float slope = exp2f(-(float)(h + 1));
    const float q = proj[(size_t)tok * D_IN + C_Q + h * 64 + lane] * 0.125f;
    const float sink = sinks[h];
    float m = sink, l = 1.f, o = 0.f;
    const int n = (t + 1 < 128) ? t + 1 : 128;
    for (int j = 0; j < n; ++j) {
        const size_t ko = (size_t)(tok - j) * D_IN;
        float s = wave_sum(q * proj[ko + C_K + kvh * 64 + lane]) - slope * (float)j;
        const float mn = fmaxf(m, s), a = __expf(m - mn), p = __expf(s - mn);
        l = l * a + p; o = o * a + p * proj[ko + C_V + kvh * 64 + lane]; m = mn;
    }
    Y[(size_t)tok * D_MIX + 512 + h * 64 + lane] = (o / l) * silu_f(proj[(size_t)tok * D_IN + C_GATTN + h * 64 + lane]);
}

extern "C" void kernel_launch(void* const* d_in, const int* in_sizes, int n_in, void* d_out, int out_size, void* d_ws, size_t ws_size, hipStream_t stream) {
    const float* x = (const float*)d_in[0];
    const float* ln_g = (const float*)d_in[1];
    const float* w_in = (const float*)d_in[2];
    const float* pool_w = (const float*)d_in[3];
    const float* pool_scale = (const float*)d_in[4];
    const float* conv_dw = (const float*)d_in[5];
    const float* conv_b = (const float*)d_in[6];
    const float* conv_ln_g = (const float*)d_in[7];
    const float* conv_ln_b = (const float*)d_in[8];
    const float* conv_pw = (const float*)d_in[9];
    const float* attn_sinks = (const float*)d_in[10];
    const float* w_out = (const float*)d_in[11];
    const float* final_g = (const float*)d_in[12];
    float* out = (float*)d_out;
    const size_t MiB = 1u << 20;
    if (ws_size < 256 * MiB) { fprintf(stderr, "ws too small\n"); return; }
    char* ws = (char*)d_ws;
    float* PROJ = (float*)(ws);
    float* HY = (float*)(ws + 160 * MiB);
    float* DIFF = (float*)(ws + 224 * MiB);
    float* HN = (float*)(ws + 240 * MiB);
    for (int l = 0; l < DEPTH; ++l) {
        const float* xin = l == 0 ? x : out;
        k_rmsnorm<<<M_TOK / 4, 256, 0, stream>>>(xin, ln_g + l * D_MODEL, HY);
        k_gemm<<<dim3(D_IN / 64, M_TOK / 64), 256, 0, stream>>>(HY, w_in + (size_t)l * D_MODEL * D_IN, PROJ, nullptr, M_TOK, D_IN, D_MODEL);
        k_pool_diff<<<M_TOK, 256, 0, stream>>>(PROJ, DIFF);
        k_pool_out<<<M_TOK, 256, 0, stream>>>(PROJ, DIFF, pool_w + l * 4 * 64 * 64, pool_scale + l * 256, HY);
        k_conv<<<M_TOK, 256, 0, stream>>>(PROJ, conv_dw + l * 31 * 256, conv_b + l * 256, conv_ln_g + l * 256, conv_ln_b + l * 256, HN);
        k_conv_pw<<<M_TOK, 256, 0, stream>>>(PROJ, HN, conv_pw + l * 256 * 256, HY);
        k_attn<<<M_TOK, 512, 0, stream>>>(PROJ, attn_sinks + l * 8, HY);
        k_gemm<<<dim3(D_MODEL / 64, M_TOK / 64), 256, 0, stream>>>(HY, w_out + (size_t)l * D_MIX * D_MODEL, out, xin, M_TOK, D_MODEL, D_MIX);
    }
    k_rmsnorm<<<M_TOK / 4, 256, 0, stream>>>(out, final_g, out);
}
```

```cpp
#include <hip/hip_runtime.h>
#include <cstdio>
#include <cstdint>
namespace pg8 {
#define PG8_LAS __attribute__((address_space(3)))
typedef unsigned short bf16_t;
typedef short bf16x8 __attribute__((ext_vector_type(8)));
typedef float f32x4 __attribute__((ext_vector_type(4)));
typedef unsigned u32x4 __attribute__((ext_vector_type(4)));
constexpr int BM = 256, BK = 64, HALF = 128, HTB = HALF * BK * 2  , STAGE_BYTES = 8 * HTB, NXCD = 8, WGM = 8;

__host__ __device__ __forceinline__ int lds_byte(int r, int c) { const int st = (r >> 4) * 2 + (c >> 5), rr = r & 15, cc = c & 31, ob = rr * 64 + cc * 2; return st * 1024 + (ob ^ (((ob >> 9) & 1) << 5)); }
__host__ __device__ __forceinline__ void stage_rc(int b, int& R, int& C) { const int st = b / 1024, sb = b % 1024, swz = sb ^ (((sb >> 9) & 1) << 5); R = (st >> 1) * 16 + swz / 64; C = (st & 1) * 32 + (swz % 64) / 2; }
__host__ __device__ __forceinline__ int perm32(int rho) { const int n = rho >> 4, i = rho & 15; return 8 * (i >> 2) + 4 * n + (i & 3); }

struct Unit { int pm, pn; };
struct Gemm { const bf16_t* A; const bf16_t* Bt; int M, N, K; };

struct StaticOrder {
    int nM, nN, nwg, G, c;
    __host__ __device__ void init(int M, int N, int G_, int c_) { nM = M / BM; nN = N / BM; nwg = nM * nN; G = G_; c = c_; }
    __host__ __device__ bool next(int i, Unit& u) const {
        const long L = (long)i * G + c; if (L >= nwg) return false;
        int wgid = (int)L; { const int q = nwg / NXCD, r = nwg % NXCD, xcd = wgid % NXCD, off = wgid / NXCD; wgid = (xcd < r ? xcd * (q + 1) : r * (q + 1) + (xcd - r) * q) + off; }
        const int nig = WGM * nN, gid = wgid / nig, fm = gid * WGM, gsz = (nM - fm) < WGM ? (nM - fm) : WGM;
        u.pm = fm + ((wgid % nig) % gsz); u.pn = (wgid % nig) / gsz; return true;
    }
    __device__ __forceinline__ void a_ready(const Unit&) const {}
    __device__ __forceinline__ void done(const Unit&) const {}
};

__device__ __forceinline__ unsigned cvt_pk_bf16(float lo, float hi) { unsigned r; asm volatile("v_cvt_pk_bf16_f32 %0, %1, %2" : "=v"(r) : "v"(lo), "v"(hi)); return r; }
typedef float f32x2 __attribute__((ext_vector_type(2)));
typedef unsigned u32x2 __attribute__((ext_vector_type(2)));
struct EpiProj {
    static constexpr bool PERM = true, AFTER_DRAIN = false;
    bf16_t* O; int ldc; const float* ssp;
    __device__ __forceinline__ void operator()(const f32x4 (&acc)[2][2][4][2], const Unit& u, int wr, int wc, int fr, int fq) const {
        const int row0 = u.pm * BM + wr * 64 + fr, col0 = u.pn * BM + wc * 32 + 8 * fq;
#pragma unroll
        for (int ai = 0; ai < 2; ++ai)
#pragma unroll
            for (int m = 0; m < 4; ++m) {
                const int row = row0 + ai * HALF + m * 16;
                const f32x4 s = *(const f32x4*)(ssp + (size_t)row * 4);
                const float rs = rsqrtf(((s[0] + s[1]) + (s[2] + s[3])) * (1.0f / 1024.0f) + 1e-6f);
                bf16_t* rowp = O + (size_t)row * ldc + col0;
#pragma unroll
                for (int bj = 0; bj < 2; ++bj) { const f32x4 v0 = acc[ai][bj][m][0] * rs, v1 = acc[ai][bj][m][1] * rs;
                    u32x4 w; w.x = cvt_pk_bf16(v0[0], v0[1]); w.y = cvt_pk_bf16(v0[2], v0[3]); w.z = cvt_pk_bf16(v1[0], v1[1]); w.w = cvt_pk_bf16(v1[2], v1[3]);
                    *(u32x4*)(rowp + bj * HALF) = w; }
            }
    }
};
struct EpiRes {
    static constexpr bool PERM = false, AFTER_DRAIN = true;
    const float* base; float* out; bf16_t* xb; float* ssp; int ldc;
    __device__ __forceinline__ void fused(f32x4 (&acc)[2][2][4][2], const Unit& u, int wr, int wc, int fr, int fq, PG8_LAS unsigned char* lds, int wid, int lane) const {
        PG8_LAS float* P = (PG8_LAS float*)lds;
        const int col0 = u.pn * BM + wc * 32 + 4 * fq;
#pragma unroll
        for (int ai = 0; ai < 2; ++ai)
#pragma unroll
            for (int m = 0; m < 4; ++m) { const int r = ai * HALF + wr * 64 + m * 16 + fr; const size_t off = (size_t)(u.pm * BM + r) * ldc + col0; float s = 0.f;
#pragma unroll
                for (int bj = 0; bj < 2; ++bj)
#pragma unroll
                    for (int n = 0; n < 2; ++n) { const f32x4 bs = *(const f32x4*)(base + off + bj * HALF + n * 16); const f32x4 o = bs + acc[ai][bj][m][n];
                        *(f32x4*)(out + off + bj * HALF + n * 16) = o;
                        u32x2 w; w.x = cvt_pk_bf16(o[0], o[1]); w.y = cvt_pk_bf16(o[2], o[3]); *(u32x2*)(xb + off + bj * HALF + n * 16) = w;
                        s += (o[0] * o[0] + o[1] * o[1]) + (o[2] * o[2] + o[3] * o[3]); }
                s += __shfl_xor(s, 16); s += __shfl_xor(s, 32);
                if (fq == 0) P[r * 4 + wc] = s;
                if (m & 1) asm volatile("" ::: "memory"); }
        asm volatile("s_waitcnt lgkmcnt(0)" ::: "memory"); __builtin_amdgcn_s_barrier(); asm volatile("" ::: "memory");
        const int tid = wid * 64 + lane;
        if (tid < 256) { const f32x4 p = *(const PG8_LAS f32x4*)(P + tid * 4); ssp[(size_t)(u.pm * BM + tid) * 4 + u.pn] = (p[0] + p[1]) + (p[2] + p[3]); }
        asm volatile("s_waitcnt lgkmcnt(0)" ::: "memory"); __builtin_amdgcn_s_barrier(); asm volatile("" ::: "memory");
    }
};
template <class Epi, class Sched, bool ALIGN_EPI = false, bool SP2 = false>
__device__ __forceinline__ void gemm_phase(PG8_LAS unsigned char* lds, const Gemm g, const Sched& S, const Epi& E) {
    int tid_ = threadIdx.x; asm volatile("" : "+v"(tid_));
    const int tid = tid_, wid = __builtin_amdgcn_readfirstlane(tid >> 6), lane = tid & 63, wr = wid >> 2, wc = wid & 3, fr = lane & 15, fq = lane >> 4;
    const int K = g.K, nt = K / BK;
    unsigned voffA[2], voffB[2];
#pragma unroll
    for (int i = 0; i < 2; ++i) { int R, C; stage_rc(tid * 16 + i * 8192, R, C); const int Rb = Epi::PERM ? ((R & ~31) + perm32(R & 31)) : R;
        voffA[i] = (unsigned)(R * K + C) * 2u; voffB[i] = (unsigned)(Rb * K + C) * 2u; }
    const size_t kstep = (size_t)(BK * 2);
    const size_t hstep = (size_t)HALF * K * 2;
    const size_t tstep = 2 * hstep;
    const unsigned ldsw = (unsigned)wid * 1024u;
    const int aoff = lds_byte(wr * 64 + fr, fq * 8), boff = lds_byte(wc * 32 + fr, fq * 8);
#define PG8_SA(b, h) (((b) * 2 + (h)) * HTB)
#define PG8_SB(b, h) ((4 + (b) * 2 + (h)) * HTB)
#define PG8_STAGE(bufoff, gbase, voff) do { _Pragma("unroll") for (int _i = 0; _i < 2; ++_i) \
        __builtin_amdgcn_global_load_lds((const unsigned*)((const char*)(gbase) + (voff)[_i]), (PG8_LAS unsigned*)(lds + (bufoff) + ldsw + _i * 8192), 16, 0, 0); } while (0)
#define PG8_LDA(dst, b, h) do { _Pragma("unroll") for (int m = 0; m < 4; ++m) _Pragma("unroll") for (int k = 0; k < 2; ++k) dst[m][k] = *(const PG8_LAS bf16x8*)(lds + PG8_SA(b, h) + aoff + m * 2048 + k * 1024); } while (0)
#define PG8_LDB(dst, b, h) do { _Pragma("unroll") for (int n = 0; n < 2; ++n) _Pragma("unroll") for (int k = 0; k < 2; ++k) dst[n][k] = *(const PG8_LAS bf16x8*)(lds + PG8_SB(b, h) + boff + n * 2048 + k * 1024); } while (0)
#define PG8_MMA(ai, bj, At, Bt) do { __builtin_amdgcn_s_setprio(1); _Pragma("unroll") for (int m = 0; m < 4; ++m) _Pragma("unroll") for (int n = 0; n < 2; ++n) _Pragma("unroll") for (int k = 0; k < 2; ++k) \
        acc[ai][bj][m][n] = __builtin_amdgcn_mfma_f32_16x16x32_bf16(Bt[n][k], At[m][k], acc[ai][bj][m][n], 0, 0, 0); __builtin_amdgcn_s_setprio(0); } while (0)
#define PG8_WAIT_V(n) asm volatile("s_waitcnt vmcnt(" #n ")" ::: "memory")
#define PG8_WAIT_L(n) asm volatile("s_waitcnt lgkmcnt(" #n ")" ::: "memory")
#define PG8_BAR __builtin_amdgcn_s_barrier()
#define PG8_SCHED __builtin_amdgcn_sched_barrier(0)
    Unit cur, nxt; int ui = 0;
    if (!S.next(0, cur)) return;
    f32x4 acc[2][2][4][2];
#pragma unroll
    for (int a = 0; a < 2; ++a)
#pragma unroll
        for (int b = 0; b < 2; ++b)
#pragma unroll
            for (int m = 0; m < 4; ++m)
#pragma unroll
                for (int n = 0; n < 2; ++n) acc[a][b][m][n] = (f32x4){0.f, 0.f, 0.f, 0.f};
    bf16x8 At[4][2], B0[2][2], B1[2][2];
    const char* cA = (const char*)g.A + (size_t)cur.pm * tstep; const char* cB = (const char*)g.Bt + (size_t)cur.pn * tstep;
    S.a_ready(cur);
    if constexpr (SP2) {
        PG8_STAGE(PG8_SB(0, 0), cB, voffB); PG8_STAGE(PG8_SB(0, 1), cB + hstep, voffB); PG8_STAGE(PG8_SA(0, 0), cA, voffA); PG8_STAGE(PG8_SA(0, 1), cA + hstep, voffA);
        if (wr == 1) PG8_BAR;
        PG8_WAIT_V(2); PG8_BAR;
        PG8_STAGE(PG8_SB(1, 0), cB + kstep, voffB); PG8_STAGE(PG8_SA(1, 0), cA + kstep, voffA); PG8_STAGE(PG8_SB(1, 1), cB + hstep + kstep, voffB);
        PG8_WAIT_V(6); PG8_BAR;
    } else {
        PG8_STAGE(PG8_SB(0, 0), cB, voffB); PG8_STAGE(PG8_SA(0, 0), cA, voffA); PG8_STAGE(PG8_SB(0, 1), cB + hstep, voffB); PG8_STAGE(PG8_SA(0, 1), cA + hstep, voffA);
        if (wr == 1) PG8_BAR;
        PG8_WAIT_V(4); PG8_BAR;
        PG8_STAGE(PG8_SB(1, 0), cB + kstep, voffB); PG8_STAGE(PG8_SA(1, 0), cA + kstep, voffA); PG8_STAGE(PG8_SB(1, 1), cB + hstep + kstep, voffB);
        PG8_WAIT_V(6); PG8_BAR;
    }
    for (;;) {
        const bool has_next = S.next(ui + 1, nxt);
        const char* nA = has_next ? (const char*)g.A + (size_t)nxt.pm * tstep : cA; const char* nB = has_next ? (const char*)g.Bt + (size_t)nxt.pn * tstep : cB;
        for (int t = 0; t < nt; t += 2) {
            const bool last = (t == nt - 2);
            const char* a1 = cA + (size_t)(t + 1) * kstep;
            const char* a2 = last ? nA : cA + (size_t)(t + 2) * kstep; const char* b2 = last ? nB : cB + (size_t)(t + 2) * kstep;
            const char* a3 = a2 + kstep; const char* b3 = b2 + kstep;
            if (last && has_next) S.a_ready(nxt);
            if constexpr (SP2) {
            PG8_LDB(B0, 0, 0); PG8_LDB(B1, 0, 1); PG8_SCHED; PG8_LDA(At, 0, 0); PG8_STAGE(PG8_SA(1, 1), a1 + hstep, voffA);
            PG8_WAIT_V(8); PG8_WAIT_L(0); PG8_BAR; PG8_MMA(0, 0, At, B0); PG8_MMA(0, 1, At, B1); PG8_BAR; PG8_SCHED;
            PG8_LDA(At, 0, 1); PG8_STAGE(PG8_SB(0, 0), b2, voffB); PG8_STAGE(PG8_SB(0, 1), b2 + hstep, voffB); PG8_STAGE(PG8_SA(0, 0), a2, voffA);
            PG8_WAIT_V(8); PG8_WAIT_L(0); PG8_BAR; PG8_MMA(1, 0, At, B0); PG8_MMA(1, 1, At, B1); PG8_BAR; PG8_SCHED;
            PG8_LDB(B0, 1, 0); PG8_LDB(B1, 1, 1); PG8_SCHED; PG8_LDA(At, 1, 0); PG8_STAGE(PG8_SA(0, 1), a2 + hstep, voffA);
            PG8_WAIT_V(8); PG8_WAIT_L(0); PG8_BAR; PG8_MMA(0, 0, At, B0); PG8_MMA(0, 1, At, B1); PG8_BAR; PG8_SCHED;
            PG8_LDA(At, 1, 1); PG8_STAGE(PG8_SB(1, 0), b3, voffB); PG8_STAGE(PG8_SB(1, 1), b3 + hstep, voffB); PG8_STAGE(PG8_SA(1, 0), a3, voffA);
            PG8_WAIT_V(8); PG8_WAIT_L(0); PG8_BAR; PG8_MMA(1, 0, At, B0); PG8_MMA(1, 1, At, B1); PG8_BAR; PG8_SCHED;
            } else {
            PG8_LDB(B0, 0, 0); PG8_SCHED; PG8_LDA(At, 0, 0); PG8_STAGE(PG8_SA(1, 1), a1 + hstep, voffA);
            PG8_WAIT_L(8); PG8_BAR; PG8_WAIT_L(0); PG8_MMA(0, 0, At, B0); PG8_BAR; PG8_SCHED;
            PG8_LDB(B1, 0, 1); PG8_STAGE(PG8_SB(0, 0), b2, voffB);
            PG8_BAR; PG8_WAIT_L(0); PG8_MMA(0, 1, At, B1); PG8_BAR;
            PG8_LDA(At, 0, 1); PG8_STAGE(PG8_SA(0, 0), a2, voffA);
            PG8_BAR; PG8_WAIT_L(0); PG8_MMA(1, 0, At, B0); PG8_BAR; PG8_SCHED;
            PG8_STAGE(PG8_SB(0, 1), b2 + hstep, voffB);
            PG8_WAIT_V(6); PG8_BAR; PG8_MMA(1, 1, At, B1); PG8_BAR;
            PG8_LDB(B0, 1, 0); PG8_SCHED; PG8_LDA(At, 1, 0); PG8_STAGE(PG8_SA(0, 1), a2 + hstep, voffA);
            PG8_WAIT_L(8); PG8_BAR; PG8_WAIT_L(0); PG8_MMA(0, 0, At, B0); PG8_BAR; PG8_SCHED;
            PG8_LDB(B1, 1, 1); PG8_STAGE(PG8_SB(1, 0), b3, voffB);
            PG8_BAR; PG8_WAIT_L(0); PG8_MMA(0, 1, At, B1); PG8_BAR;
            PG8_LDA(At, 1, 1); PG8_STAGE(PG8_SA(1, 0), a3, voffA);
            PG8_BAR; PG8_WAIT_L(0); PG8_MMA(1, 0, At, B0); PG8_BAR; PG8_SCHED;
            PG8_STAGE(PG8_SB(1, 1), b3 + hstep, voffB);
            PG8_WAIT_V(6); PG8_BAR; PG8_MMA(1, 1, At, B1); PG8_BAR;
            }
        }
        if constexpr (ALIGN_EPI) { if (wr == 0) PG8_BAR; }
        if constexpr (!Epi::AFTER_DRAIN) { E(acc, cur, wr, wc, fr, fq); S.done(cur); }
        if (!has_next) break;
#pragma unroll
        for (int a = 0; a < 2; ++a)
#pragma unroll
            for (int b = 0; b < 2; ++b)
#pragma unroll
                for (int m = 0; m < 4; ++m)
#pragma unroll
                    for (int n = 0; n < 2; ++n) acc[a][b][m][n] = (f32x4){0.f, 0.f, 0.f, 0.f};
        cur = nxt; cA = nA; cB = nB; ++ui;
        if constexpr (ALIGN_EPI) { if (wr == 1) PG8_BAR; }
    }
    PG8_WAIT_V(0);
    if constexpr (!ALIGN_EPI) { if (wr == 0) PG8_BAR; }
    PG8_BAR;
    if constexpr (Epi::AFTER_DRAIN) { E.fused(acc, cur, wr, wc, fr, fq, lds, wid, lane); S.done(cur); }
#undef PG8_SA
#undef PG8_SB
#undef PG8_STAGE
#undef PG8_LDA
#undef PG8_LDB
#undef PG8_MMA
#undef PG8_WAIT_V
#undef PG8_WAIT_L
#undef PG8_BAR
#undef PG8_SCHED
}
}
constexpr int NWAVES = 8;
#ifndef MK_N_LAUNCHES
#define MK_N_LAUNCHES 1
#endif
constexpr int N_LAUNCHES = MK_N_LAUNCHES;
constexpr int NPH = 8;
constexpr int D = 1024, BATCH = 2, SEQ = 8192, M = BATCH * SEQ, DIN = 2560, DEPTH = 2;
constexpr int C_UPOOL = 0, C_GPOOL = 256, C_CA = 512, C_CB = 768, C_GCONV = 1024, C_Q = 1280, C_K = 1792, C_V = 1920, C_GATTN = 2048;
constexpr float EPS = 1e-6f;
constexpr size_t MiB = 1u << 20;
constexpr size_t WS_CTL = 0, CTL_ZERO_BYTES = 1 * MiB;
constexpr size_t WS_WIN = 2 * MiB;
constexpr size_t WS_WOUT = 12 * MiB;
constexpr size_t WS_WPW = 16 * MiB;
constexpr size_t WS_WPOOL = 16 * MiB + 512 * 1024;
constexpr size_t WS_SSP = 17 * MiB;
constexpr size_t WS_XB = 32 * MiB;
constexpr size_t WS_PROJ = 64 * MiB;
constexpr size_t WS_Y = 144 * MiB;
constexpr size_t WS_END = 176 * MiB;
constexpr int CW_BAR = 4096;
constexpr int RING_OFF = 0, RING_BYTES = 131072, LDSCTL_OFF = RING_BYTES, MISC_OFF = LDSCTL_OFF + 320, LDS_BYTES = 147456;
#define GAS __attribute__((address_space(1)))
#define LAS __attribute__((address_space(3)))
typedef unsigned short bf16;
typedef unsigned v4u __attribute__((ext_vector_type(4)));
typedef float f32x4 __attribute__((ext_vector_type(4)));
typedef short bf16x8 __attribute__((ext_vector_type(8)));
typedef GAS unsigned gu32;
typedef GAS unsigned long long gu64;
#define RLX_AGENT __ATOMIC_RELAXED, __HIP_MEMORY_SCOPE_AGENT
#define LDS_WAIT() asm volatile("s_waitcnt lgkmcnt(0)" ::: "memory")
#define VM_WAIT() asm volatile("s_waitcnt vmcnt(0)" ::: "memory")
__device__ __forceinline__ unsigned long long rt() { return __builtin_amdgcn_s_memrealtime(); }
__device__ __forceinline__ unsigned f2bf(float f) { unsigned u = __builtin_bit_cast(unsigned, f); return (u + 0x7fffu + ((u >> 16) & 1u)) >> 16; }
__device__ __forceinline__ unsigned pk2(float lo, float hi) { return f2bf(lo) | (f2bf(hi) << 16); }
#define XB_TMO      128
#define XB_XCNT(j)  (256  + 64 * (j))
#define XB_XSUB(j)  (1280 + 64 * (j))
#define XB_XGEN(j)  (2304 + 64 * (j))
#define XB_TOP      3328
#define XB_TOPGEN   3392
#define XCD_BAR_WORDS 3456
#define XB_SPIN_CAP (1u << 18)

__device__ __forceinline__ unsigned xb_ld(unsigned* p)              { return __hip_atomic_load(p, __ATOMIC_RELAXED, __HIP_MEMORY_SCOPE_AGENT); }
__device__ __forceinline__ unsigned xb_add(unsigned* p, unsigned v) { return __hip_atomic_fetch_add(p, v, __ATOMIC_RELAXED, __HIP_MEMORY_SCOPE_AGENT); }
__device__ __forceinline__ unsigned xb_xcc_id() { return (unsigned)__builtin_amdgcn_s_getreg((3 << 11) | 20) & 0xFu; }
#define XB_SPIN(cond, bar) do { unsigned _sp = 0; while (cond) { __builtin_amdgcn_s_sleep(1); \
    if ((++_sp & 255u) == 0u) { if (xb_ld(&(bar)[XB_TMO])) break; if (_sp > XB_SPIN_CAP) { atomicAdd(&(bar)[XB_TMO], 1u); break; } } } } while (0)

struct XcdBarrier {
    unsigned* bar; unsigned x;
    volatile LAS unsigned* st;
};

__device__ __forceinline__ XcdBarrier xcd_barrier_post(unsigned* bar, volatile LAS unsigned* st) {
    XcdBarrier b; b.bar = bar; b.x = xb_xcc_id(); b.st = st;
    if (threadIdx.x == 0) (void)xb_add(&bar[XB_XCNT(b.x)], 1u);
    return b;
}
__device__ __forceinline__ void xcd_barrier_complete(unsigned* bar, unsigned x, unsigned& nloc, unsigned& nx) {
    const unsigned G = gridDim.x * gridDim.y * gridDim.z;
    unsigned sum, cnt, mine, sp = 0u;
    for (;;) {
        sum = 0u; cnt = 0u; mine = 0u;
#pragma unroll
        for (unsigned j = 0; j < 16; ++j) { const unsigned c = xb_ld(&bar[XB_XCNT(j)]); sum += c; cnt += (c > 0u) ? 1u : 0u; mine = (j == x) ? c : mine; }
        if (sum == G) break;
        __builtin_amdgcn_s_sleep(1);
        if ((++sp & 255u) == 0u) { if (xb_ld(&bar[XB_TMO])) break; if (sp > XB_SPIN_CAP) { atomicAdd(&bar[XB_TMO], 1u); break; } }
    }
    nloc = mine > 0u ? mine : 1u; nx = cnt > 0u ? cnt : 1u;
}

__device__ __forceinline__ void xcd_barrier(const XcdBarrier& b) {
    asm volatile("s_waitcnt vmcnt(0)" ::: "memory");
    __syncthreads();
    if (threadIdx.x == 0) {
        unsigned* bar = b.bar;
        __builtin_amdgcn_s_waitcnt(0);
        unsigned nloc = b.st[0], nx = b.st[1];
        if (nloc == 0u) { xcd_barrier_complete(bar, b.x, nloc, nx); b.st[0] = nloc; b.st[1] = nx; }
        const unsigned old = xb_add(&bar[XB_XSUB(b.x)], 1u);
        const unsigned gen = old / nloc;
        if (old + 1u == (gen + 1u) * nloc) {
            __builtin_amdgcn_fence(__ATOMIC_RELEASE, "agent");
            asm volatile("s_waitcnt vmcnt(0)" ::: "memory");
            const unsigned og = xb_add(&bar[XB_TOP], 1u);
            const unsigned tg = og / nx;
            if (og + 1u == (tg + 1u) * nx) xb_add(&bar[XB_TOPGEN], 1u);
            else XB_SPIN(xb_ld(&bar[XB_TOPGEN]) == tg, bar);
            __builtin_amdgcn_fence(__ATOMIC_ACQUIRE, "agent");
            xb_add(&bar[XB_XGEN(b.x)], 1u);
            asm volatile("s_waitcnt vmcnt(0)" ::: "memory");
        } else {
            XB_SPIN(xb_ld(&bar[XB_XGEN(b.x)]) == gen, bar);
            __builtin_amdgcn_fence(__ATOMIC_ACQUIRE, "agent");
            asm volatile("s_waitcnt vmcnt(0)" ::: "memory");
        }
    }
    __syncthreads();
}
__device__ __forceinline__ float bf2f(bf16 v) { return __uint_as_float((unsigned)v << 16); }
__device__ __forceinline__ float wave_sum(float v) {
#pragma unroll
    for (int o = 1; o < 64; o <<= 1) v += __shfl_xor(v, o);
    return v;
}
__device__ __forceinline__ float silu_f(float x) { return x / (1.f + __expf(-x)); }
__device__ __forceinline__ float sigmoid_f(float x) { return 1.f / (1.f + __expf(-x)); }

__device__ __forceinline__ void p0_transpose_item(const float* W, int K, int N, bf16* WT, LAS float* scr, int item, int lane, const float* kscale) {
    const int nblk = N / 32, kb = item / nblk, nb = item % nblk, k0 = 64 * kb, n0 = 32 * nb;
#pragma unroll 8
    for (int i = 0; i < 32; ++i) { const int kk = 2 * i + (lane >> 5); float v = W[(size_t)(k0 + kk) * N + n0 + (lane & 31)]; if (kscale) v *= kscale[k0 + kk]; scr[kk * 33 + (lane & 31)] = v; }
    LDS_WAIT(); asm volatile("" ::: "memory");
    const int c = lane & 7;
#pragma unroll
    for (int j = 0; j < 4; ++j) { const int n = (lane >> 3) + 8 * j; const LAS float* s = scr + (8 * c) * 33 + n;
        v4u o; o.x = pk2(s[0 * 33], s[1 * 33]); o.y = pk2(s[2 * 33], s[3 * 33]); o.z = pk2(s[4 * 33], s[5 * 33]); o.w = pk2(s[6 * 33], s[7 * 33]);
        *(GAS v4u*)(WT + (size_t)(n0 + n) * K + k0 + 8 * c) = o; }
    LDS_WAIT(); asm volatile("" ::: "memory");
}

struct Args { const float* in[13]; float* out; unsigned char* ws; int ph_lo, ph_hi; };

__global__ void __launch_bounds__(NWAVES * 64, 2) fwd(Args args) {
    extern __shared__ __attribute__((aligned(16))) unsigned char lds[];
    LAS unsigned char* L = (LAS unsigned char*)lds;
    volatile LAS unsigned* MISC = (volatile LAS unsigned*)(L + MISC_OFF);
    const int tid = threadIdx.x, lane = tid & 63, wave = __builtin_amdgcn_readfirstlane(tid >> 6);
    const int G = gridDim.x;
    unsigned char* ws = args.ws;
    gu32* ctl = (gu32*)(ws + WS_CTL);
    const float* x = args.in[0]; const float* ln_g = args.in[1]; const float* w_in = args.in[2]; const float* pool_w = args.in[3]; const float* pool_scale = args.in[4];
    const float* conv_dw = args.in[5]; const float* conv_b = args.in[6]; const float* conv_ln_g = args.in[7]; const float* conv_ln_b = args.in[8]; const float* conv_pw = args.in[9];
    const float* attn_sinks = args.in[10]; const float* w_out = args.in[11]; const float* final_g = args.in[12];
    float* out = args.out;
    bf16* WIN = (bf16*)(ws + WS_WIN); bf16* WOUT = (bf16*)(ws + WS_WOUT); bf16* WPW = (bf16*)(ws + WS_WPW); bf16* WPOOL = (bf16*)(ws + WS_WPOOL);
    float* SSP = (float*)(ws + WS_SSP); bf16* XB = (bf16*)(ws + WS_XB); bf16* PROJ = (bf16*)(ws + WS_PROJ); bf16* Y = (bf16*)(ws + WS_Y);
    for (int u = tid; u < (LDS_BYTES - LDSCTL_OFF) / 4; u += NWAVES * 64) ((LAS unsigned*)(L + LDSCTL_OFF))[u] = 0u;
    __syncthreads();
    XcdBarrier bar; bar.bar = (unsigned*)(ctl + CW_BAR); bar.x = 0; bar.st = nullptr;
    if (N_LAUNCHES == 1) bar = xcd_barrier_post((unsigned*)(ctl + CW_BAR), MISC + 8);
    const int lo = args.ph_lo, hi = args.ph_hi;
#define IN(k) (lo <= (k) && (k) < hi)
#define SEAM(k) do { if (IN(k) && IN((k) + 1)) xcd_barrier(bar); } while (0)

    if (IN(0)) {
        LAS float* scr = (LAS float*)(L + RING_OFF + wave * 16384);
        const int gw = blockIdx.x * NWAVES + wave, NGW = G * NWAVES;
        constexpr int I_IN = (D / 64) * (DIN / 32), I_OUT = (D / 64) * (D / 32), I_PW = (256 / 64) * (256 / 32), I_PL = 2;
        constexpr int NITEMS = DEPTH * (I_IN + I_OUT + I_PW + 4 * I_PL);
        for (int it = gw; it < NITEMS; it += NGW) {
            int r = it;
            if (r < DEPTH * I_IN) { const int l = r / I_IN; p0_transpose_item(w_in + (size_t)l * D * DIN, D, DIN, WIN + (size_t)l * DIN * D, scr, r % I_IN, lane, ln_g + l * D); continue; } r -= DEPTH * I_IN;
            if (r < DEPTH * I_OUT) { const int l = r / I_OUT; p0_transpose_item(w_out + (size_t)l * D * D, D, D, WOUT + (size_t)l * D * D, scr, r % I_OUT, lane, nullptr); continue; } r -= DEPTH * I_OUT;
            if (r < DEPTH * I_PW) { const int l = r / I_PW; p0_transpose_item(conv_pw + (size_t)l * 65536, 256, 256, WPW + (size_t)l * 65536, scr, r % I_PW, lane, nullptr); continue; } r -= DEPTH * I_PW;
            { const int lg = r / I_PL; p0_transpose_item(pool_w + (size_t)lg * 4096, 64, 64, WPOOL + (size_t)lg * 4096, scr, r % I_PL, lane, nullptr); }
        }
        for (int m = gw; m < M; m += NGW) {
            const GAS f32x4* xr = (const GAS f32x4*)(x + (size_t)m * D) + lane;
            f32x4 v[4]; float s = 0.f;
#pragma unroll
            for (int j = 0; j < 4; ++j) { v[j] = xr[64 * j]; s += (v[j].x * v[j].x + v[j].y * v[j].y) + (v[j].z * v[j].z + v[j].w * v[j].w); }
            s = wave_sum(s);
            GAS unsigned long long* o8 = (GAS unsigned long long*)(XB + (size_t)m * D) + lane;
#pragma unroll
            for (int j = 0; j < 4; ++j) o8[64 * j] = (unsigned long long)pk2(v[j].x, v[j].y) | ((unsigned long long)pk2(v[j].z, v[j].w) << 32);
            if (lane == 0) *(f32x4*)(SSP + (size_t)m * 4) = (f32x4){s, 0.f, 0.f, 0.f};
        }
    }
    SEAM(0);
    for (int l = 0; l < DEPTH; ++l) {
        const int pb = 1 + 3 * l;
        if (IN(pb)) {
            pg8::Gemm g{XB, WIN + (size_t)l * DIN * D, M, DIN, D}; pg8::StaticOrder S; S.init(M, DIN, G, (int)blockIdx.x);
            pg8::EpiProj E{PROJ, DIN, SSP + (size_t)l * M * 4};
            pg8::gemm_phase<pg8::EpiProj, pg8::StaticOrder, true, true>(L + RING_OFF, g, S, E);
        }
        SEAM(pb);
        if (IN(pb + 1)) {
            int tid = threadIdx.x; asm volatile("" : "+v"(tid));
            const int lane = tid & 63;
            LAS float* sh = (LAS float*)(L + RING_OFF);
            const float* pw_l = pool_w + (size_t)l * 16384; const float* ps_l = pool_scale + l * 256; const float* dw_l = conv_dw + l * 31 * 256; const float* cb_l = conv_b + l * 256;
            const float* lg_l = conv_ln_g + l * 256; const float* lb_l = conv_ln_b + l * 256; const float* cpw_l = conv_pw + (size_t)l * 65536; const float* sk_l = attn_sinks + l * 8;
            for (int tok = blockIdx.x; tok < M; tok += G) {
                const int t = tok & (SEQ - 1);
                const bf16* pr = PROJ + (size_t)tok * DIN;
                float cv = 0.f;
                if (tid < 256) {
                    const int c = tid, g = c >> 6, wnd = 2 << g, n = (t + 1 < wnd) ? t + 1 : wnd;
                    float s = 0.f; for (int j = 0; j < n; ++j) s += bf2f(pr[-(long)j * DIN + C_UPOOL + c]);
                    sh[c] = s / (float)n - bf2f(pr[C_UPOOL + c]);
                    cv = cb_l[c];
                    for (int j = 0; j < 31; ++j) { const int dt = 30 - j; if (t - dt >= 0) { const bf16* q = pr - (long)dt * DIN; cv += bf2f(q[C_CA + c]) * sigmoid_f(bf2f(q[C_CB + c])) * dw_l[j * 256 + c]; } }
                    const float wsum = wave_sum(cv); if (lane == 0) sh[512 + wave] = wsum;
                }
                __syncthreads();
                float dlt = 0.f;
                if (tid < 256) { const float mu = ((sh[512] + sh[513]) + (sh[514] + sh[515])) * (1.f / 256.f); dlt = cv - mu; const float wq = wave_sum(dlt * dlt); if (lane == 0) sh[520 + wave] = wq; }
                __syncthreads();
                if (tid < 256) { const float var = ((sh[520] + sh[521]) + (sh[522] + sh[523])) * (1.f / 256.f); const float yv = dlt * rsqrtf(var + EPS) * lg_l[tid] + lb_l[tid]; sh[256 + tid] = silu_f(yv); }
                __syncthreads();
                if (tid < 256) {
                    const int d = tid, g = d >> 6, dd = d & 63;
                    float s = 0.f; for (int c = 0; c < 64; ++c) s += sh[g * 64 + c] * pw_l[(g * 64 + c) * 64 + dd];
                    s *= ps_l[d];
                    Y[(size_t)tok * D + d] = (bf16)f2bf(s * silu_f(bf2f(pr[C_GPOOL + d])));
                    float s2 = 0.f; for (int c = 0; c < 256; ++c) s2 += sh[256 + c] * cpw_l[c * 256 + d];
                    Y[(size_t)tok * D + 256 + d] = (bf16)f2bf(s2 * silu_f(bf2f(pr[C_GCONV + d])));
                }
                {
                    const int h = wave, kvh = h >> 2;
                    const float slope = exp2f(-(float)(h + 1));
                    const float q = bf2f(pr[C_Q + h * 64 + lane]) * 0.125f;
                    float mx = sk_l[h], den = 1.f, o = 0.f;
                    const int n = (t + 1 < 128) ? t + 1 : 128;
                    for (int j = 0; j < n; ++j) {
                        const bf16* kr = pr - (long)j * DIN;
                        const float s = wave_sum(q * bf2f(kr[C_K + kvh * 64 + lane])) - slope * (float)j;
                        const float mn = fmaxf(mx, s), a = __expf(mx - mn), p = __expf(s - mn);
                        den = den * a + p; o = o * a + p * bf2f(kr[C_V + kvh * 64 + lane]); mx = mn;
                    }
                    Y[(size_t)tok * D + 512 + h * 64 + lane] = (bf16)f2bf((o / den) * silu_f(bf2f(pr[C_GATTN + h * 64 + lane])));
                }
                __syncthreads();
            }
        }
        SEAM(pb + 1);
        if (IN(pb + 2)) {
            pg8::Gemm g{Y, WOUT + (size_t)l * D * D, M, D, D}; pg8::StaticOrder S; S.init(M, D, G, (int)blockIdx.x);
            pg8::EpiRes E{l == 0 ? x : out, out, XB, SSP + (size_t)(l + 1) * M * 4, D};
            pg8::gemm_phase<pg8::EpiRes, pg8::StaticOrder, false, true>(L + RING_OFF, g, S, E);
        }
        SEAM(pb + 2);
    }
    if (IN(7)) {
        const int gw = blockIdx.x * NWAVES + wave, NGW = G * NWAVES;
        for (int m = gw; m < M; m += NGW) {
            GAS f32x4* xr = (GAS f32x4*)(out + (size_t)m * D) + lane;
            f32x4 v[4]; float s = 0.f;
#pragma unroll
            for (int j = 0; j < 4; ++j) { v[j] = xr[64 * j]; s += (v[j].x * v[j].x + v[j].y * v[j].y) + (v[j].z * v[j].z + v[j].w * v[j].w); }
            s = wave_sum(s);
            const float rs = rsqrtf(s * (1.f / D) + EPS);
#pragma unroll
            for (int j = 0; j < 4; ++j) { const f32x4 gg = ((const GAS f32x4*)final_g)[lane + 64 * j]; xr[64 * j] = v[j] * rs * gg; }
        }
    }
#undef IN
#undef SEAM
}

extern "C" void kernel_launch(void* const* d_in, const int* in_sizes, int n_in, void* d_out, int out_size, void* d_ws, size_t ws_size, hipStream_t stream) {
    static int grid = 0;
    if (grid == 0) {
        if (n_in != 13 || in_sizes[0] != M * D || out_size != M * D || ws_size < WS_END) { fprintf(stderr, "kernel_launch: unexpected shapes (n_in %d in0 %d out %d ws %zu)\n", n_in, n_in > 0 ? in_sizes[0] : -1, out_size, ws_size); grid = -1; return; }
        int dev = 0, cus = 0, per_cu = 0;
        if (hipGetDevice(&dev) != hipSuccess || hipDeviceGetAttribute(&cus, hipDeviceAttributeMultiprocessorCount, dev) != hipSuccess) { grid = -1; return; }
        if (hipFuncSetAttribute((const void*)fwd, hipFuncAttributeMaxDynamicSharedMemorySize, LDS_BYTES) != hipSuccess) { fprintf(stderr, "kernel_launch: hipFuncSetAttribute failed\n"); grid = -1; return; }
        if (hipOccupancyMaxActiveBlocksPerMultiprocessor(&per_cu, (const void*)fwd, NWAVES * 64, LDS_BYTES) != hipSuccess || per_cu < 1) { fprintf(stderr, "kernel_launch: occupancy query says %d blocks/CU\n", per_cu); }
        (void)hipGetLastError();
        if (cus != 256) { fprintf(stderr, "kernel_launch: built for a 256-CU device, found %d\n", cus); grid = -1; return; }
        grid = cus;
    }
    if (grid < 0) return;
    if (hipMemsetAsync((char*)d_ws + WS_CTL, 0, CTL_ZERO_BYTES, stream) != hipSuccess) return;
    Args a{};
    for (int i = 0; i < 13; ++i) a.in[i] = (const float*)d_in[i];
    a.out = (float*)d_out; a.ws = (unsigned char*)d_ws;
    for (int li = 0; li < N_LAUNCHES; ++li) {
        a.ph_lo = (N_LAUNCHES == 1) ? 0 : li; a.ph_hi = (N_LAUNCHES == 1) ? NPH : li + 1;
        hipLaunchKernelGGL(fwd, dim3(grid), dim3(NWAVES * 64), LDS_BYTES, stream, a);
    }
}
```

```cpp
#include <hip/hip_runtime.h>
#include <cstdio>
#include <cstdint>
namespace pg8 {
#define PG8_LAS __attribute__((address_space(3)))
typedef unsigned short bf16_t;
typedef short bf16x8 __attribute__((ext_vector_type(8)));
typedef float f32x4 __attribute__((ext_vector_type(4)));
typedef unsigned u32x4 __attribute__((ext_vector_type(4)));
constexpr int BM = 256, BK = 64, HALF = 128, HTB = HALF * BK * 2  , STAGE_BYTES = 8 * HTB, NXCD = 8, WGM = 8;

__host__ __device__ __forceinline__ int lds_byte(int r, int c) { const int st = (r >> 4) * 2 + (c >> 5), rr = r & 15, cc = c & 31, ob = rr * 64 + cc * 2; return st * 1024 + (ob ^ (((ob >> 9) & 1) << 5)); }
__host__ __device__ __forceinline__ void stage_rc(int b, int& R, int& C) { const int st = b / 1024, sb = b % 1024, swz = sb ^ (((sb >> 9) & 1) << 5); R = (st >> 1) * 16 + swz / 64; C = (st & 1) * 32 + (swz % 64) / 2; }
__host__ __device__ __forceinline__ int perm32(int rho) { const int n = rho >> 4, i = rho & 15; return 8 * (i >> 2) + 4 * n + (i & 3); }

struct Unit { int pm, pn; };
struct Gemm { const bf16_t* A; const bf16_t* Bt; int M, N, K; };

struct StaticOrder {
    int nM, nN, nwg, G, c;
    __host__ __device__ void init(int M, int N, int G_, int c_) { nM = M / BM; nN = N / BM; nwg = nM * nN; G = G_; c = c_; }
    __host__ __device__ bool next(int i, Unit& u) const {
        const long L = (long)i * G + c; if (L >= nwg) return false;
        int wgid = (int)L; { const int q = nwg / NXCD, r = nwg % NXCD, xcd = wgid % NXCD, off = wgid / NXCD; wgid = (xcd < r ? xcd * (q + 1) : r * (q + 1) + (xcd - r) * q) + off; }
        const int nig = WGM * nN, gid = wgid / nig, fm = gid * WGM, gsz = (nM - fm) < WGM ? (nM - fm) : WGM;
        u.pm = fm + ((wgid % nig) % gsz); u.pn = (wgid % nig) / gsz; return true;
    }
    __device__ __forceinline__ void a_ready(const Unit&) const {}
    __device__ __forceinline__ void done(const Unit&) const {}
};

__device__ __forceinline__ unsigned cvt_pk_bf16(float lo, float hi) { unsigned r; asm volatile("v_cvt_pk_bf16_f32 %0, %1, %2" : "=v"(r) : "v"(lo), "v"(hi)); return r; }
typedef float f32x2 __attribute__((ext_vector_type(2)));
typedef unsigned u32x2 __attribute__((ext_vector_type(2)));
struct EpiProj {
    static constexpr bool PERM = true, AFTER_DRAIN = false;
    bf16_t* O; int ldc; const float* ssp;
    __device__ __forceinline__ void operator()(const f32x4 (&acc)[2][2][4][2], const Unit& u, int wr, int wc, int fr, int fq) const {
        const int row0 = u.pm * BM + wr * 64 + fr, col0 = u.pn * BM + wc * 32 + 8 * fq;
#pragma unroll
        for (int ai = 0; ai < 2; ++ai)
#pragma unroll
            for (int m = 0; m < 4; ++m) {
                const int row = row0 + ai * HALF + m * 16;
                const f32x4 s = *(const f32x4*)(ssp + (size_t)row * 4);
                const float rs = rsqrtf(((s[0] + s[1]) + (s[2] + s[3])) * (1.0f / 1024.0f) + 1e-6f);
                bf16_t* rowp = O + (size_t)row * ldc + col0;
#pragma unroll
                for (int bj = 0; bj < 2; ++bj) { const f32x4 v0 = acc[ai][bj][m][0] * rs, v1 = acc[ai][bj][m][1] * rs;
                    u32x4 w; w.x = cvt_pk_bf16(v0[0], v0[1]); w.y = cvt_pk_bf16(v0[2], v0[3]); w.z = cvt_pk_bf16(v1[0], v1[1]); w.w = cvt_pk_bf16(v1[2], v1[3]);
                    *(u32x4*)(rowp + bj * HALF) = w; }
            }
    }
};
struct EpiRes {
    static constexpr bool PERM = false, AFTER_DRAIN = true;
    const float* base; float* out; bf16_t* xb; float* ssp; int ldc;
    __device__ __forceinline__ void fused(f32x4 (&acc)[2][2][4][2], const Unit& u, int wr, int wc, int fr, int fq, PG8_LAS unsigned char* lds, int wid, int lane) const {
        PG8_LAS float* P = (PG8_LAS float*)lds;
        const int col0 = u.pn * BM + wc * 32 + 4 * fq;
#pragma unroll
        for (int ai = 0; ai < 2; ++ai)
#pragma unroll
            for (int m = 0; m < 4; ++m) { const int r = ai * HALF + wr * 64 + m * 16 + fr; const size_t off = (size_t)(u.pm * BM + r) * ldc + col0; float s = 0.f;
#pragma unroll
                for (int bj = 0; bj < 2; ++bj)
#pragma unroll
                    for (int n = 0; n < 2; ++n) { const f32x4 bs = *(const f32x4*)(base + off + bj * HALF + n * 16); const f32x4 o = bs + acc[ai][bj][m][n];
                        *(f32x4*)(out + off + bj * HALF + n * 16) = o;
                        u32x2 w; w.x = cvt_pk_bf16(o[0], o[1]); w.y = cvt_pk_bf16(o[2], o[3]); *(u32x2*)(xb + off + bj * HALF + n * 16) = w;
                        s += (o[0] * o[0] + o[1] * o[1]) + (o[2] * o[2] + o[3] * o[3]); }
                s += __shfl_xor(s, 16); s += __shfl_xor(s, 32);
                if (fq == 0) P[r * 4 + wc] = s;
                if (m & 1) asm volatile("" ::: "memory"); }
        asm volatile("s_waitcnt lgkmcnt(0)" ::: "memory"); __builtin_amdgcn_s_barrier(); asm volatile("" ::: "memory");
        const int tid = wid * 64 + lane;
        if (tid < 256) { const f32x4 p = *(const PG8_LAS f32x4*)(P + tid * 4); ssp[(size_t)(u.pm * BM + tid) * 4 + u.pn] = (p[0] + p[1]) + (p[2] + p[3]); }
        asm volatile("s_waitcnt lgkmcnt(0)" ::: "memory"); __builtin_amdgcn_s_barrier(); asm volatile("" ::: "memory");
    }
};
template <class Epi, class Sched, bool ALIGN_EPI = false, bool SP2 = false>
__device__ __forceinline__ void gemm_phase(PG8_LAS unsigned char* lds, const Gemm g, const Sched& S, const Epi& E) {
    int tid_ = threadIdx.x; asm volatile("" : "+v"(tid_));
    const int tid = tid_, wid = __builtin_amdgcn_readfirstlane(tid >> 6), lane = tid & 63, wr = wid >> 2, wc = wid & 3, fr = lane & 15, fq = lane >> 4;
    const int K = g.K, nt = K / BK;
    unsigned voffA[2], voffB[2];
#pragma unroll
    for (int i = 0; i < 2; ++i) { int R, C; stage_rc(tid * 16 + i * 8192, R, C); const int Rb = Epi::PERM ? ((R & ~31) + perm32(R & 31)) : R;
        voffA[i] = (unsigned)(R * K + C) * 2u; voffB[i] = (unsigned)(Rb * K + C) * 2u; }
    const size_t kstep = (size_t)(BK * 2);
    const size_t hstep = (size_t)HALF * K * 2;
    const size_t tstep = 2 * hstep;
    const unsigned ldsw = (unsigned)wid * 1024u;
    const int aoff = lds_byte(wr * 64 + fr, fq * 8), boff = lds_byte(wc * 32 + fr, fq * 8);
#define PG8_SA(b, h) (((b) * 2 + (h)) * HTB)
#define PG8_SB(b, h) ((4 + (b) * 2 + (h)) * HTB)
#define PG8_STAGE(bufoff, gbase, voff) do { _Pragma("unroll") for (int _i = 0; _i < 2; ++_i) \
        __builtin_amdgcn_global_load_lds((const unsigned*)((const char*)(gbase) + (voff)[_i]), (PG8_LAS unsigned*)(lds + (bufoff) + ldsw + _i * 8192), 16, 0, 0); } while (0)
#define PG8_LDA(dst, b, h) do { _Pragma("unroll") for (int m = 0; m < 4; ++m) _Pragma("unroll") for (int k = 0; k < 2; ++k) dst[m][k] = *(const PG8_LAS bf16x8*)(lds + PG8_SA(b, h) + aoff + m * 2048 + k * 1024); } while (0)
#define PG8_LDB(dst, b, h) do { _Pragma("unroll") for (int n = 0; n < 2; ++n) _Pragma("unroll") for (int k = 0; k < 2; ++k) dst[n][k] = *(const PG8_LAS bf16x8*)(lds + PG8_SB(b, h) + boff + n * 2048 + k * 1024); } while (0)
#define PG8_MMA(ai, bj, At, Bt) do { __builtin_amdgcn_s_setprio(1); _Pragma("unroll") for (int m = 0; m < 4; ++m) _Pragma("unroll") for (int n = 0; n < 2; ++n) _Pragma("unroll") for (int k = 0; k < 2; ++k) \
        acc[ai][bj][m][n] = __builtin_amdgcn_mfma_f32_16x16x32_bf16(Bt[n][k], At[m][k], acc[ai][bj][m][n], 0, 0, 0); __builtin_amdgcn_s_setprio(0); } while (0)
#define PG8_WAIT_V(n) asm volatile("s_waitcnt vmcnt(" #n ")" ::: "memory")
#define PG8_WAIT_L(n) asm volatile("s_waitcnt lgkmcnt(" #n ")" ::: "memory")
#define PG8_BAR __builtin_amdgcn_s_barrier()
#define PG8_SCHED __builtin_amdgcn_sched_barrier(0)
    Unit cur, nxt; int ui = 0;
    if (!S.next(0, cur)) return;
    f32x4 acc[2][2][4][2];
#pragma unroll
    for (int a = 0; a < 2; ++a)
#pragma unroll
        for (int b = 0; b < 2; ++b)
#pragma unroll
            for (int m = 0; m < 4; ++m)
#pragma unroll
                for (int n = 0; n < 2; ++n) acc[a][b][m][n] = (f32x4){0.f, 0.f, 0.f, 0.f};
    bf16x8 At[4][2], B0[2][2], B1[2][2];
    const char* cA = (const char*)g.A + (size_t)cur.pm * tstep; const char* cB = (const char*)g.Bt + (size_t)cur.pn * tstep;
    S.a_ready(cur);
    if constexpr (SP2) {
        PG8_STAGE(PG8_SB(0, 0), cB, voffB); PG8_STAGE(PG8_SB(0, 1), cB + hstep, voffB); PG8_STAGE(PG8_SA(0, 0), cA, voffA); PG8_STAGE(PG8_SA(0, 1), cA + hstep, voffA);
        if (wr == 1) PG8_BAR;
        PG8_WAIT_V(2); PG8_BAR;
        PG8_STAGE(PG8_SB(1, 0), cB + kstep, voffB); PG8_STAGE(PG8_SA(1, 0), cA + kstep, voffA); PG8_STAGE(PG8_SB(1, 1), cB + hstep + kstep, voffB);
        PG8_WAIT_V(6); PG8_BAR;
    } else {
        PG8_STAGE(PG8_SB(0, 0), cB, voffB); PG8_STAGE(PG8_SA(0, 0), cA, voffA); PG8_STAGE(PG8_SB(0, 1), cB + hstep, voffB); PG8_STAGE(PG8_SA(0, 1), cA + hstep, voffA);
        if (wr == 1) PG8_BAR;
        PG8_WAIT_V(4); PG8_BAR;
        PG8_STAGE(PG8_SB(1, 0), cB + kstep, voffB); PG8_STAGE(PG8_SA(1, 0), cA + kstep, voffA); PG8_STAGE(PG8_SB(1, 1), cB + hstep + kstep, voffB);
        PG8_WAIT_V(6); PG8_BAR;
    }
    for (;;) {
        const bool has_next = S.next(ui + 1, nxt);
        const char* nA = has_next ? (const char*)g.A + (size_t)nxt.pm * tstep : cA; const char* nB = has_next ? (const char*)g.Bt + (size_t)nxt.pn * tstep : cB;
        for (int t = 0; t < nt; t += 2) {
            const bool last = (t == nt - 2);
            const char* a1 = cA + (size_t)(t + 1) * kstep;
            const char* a2 = last ? nA : cA + (size_t)(t + 2) * kstep; const char* b2 = last ? nB : cB + (size_t)(t + 2) * kstep;
            const char* a3 = a2 + kstep; const char* b3 = b2 + kstep;
            if (last && has_next) S.a_ready(nxt);
            if constexpr (SP2) {
            PG8_LDB(B0, 0, 0); PG8_LDB(B1, 0, 1); PG8_SCHED; PG8_LDA(At, 0, 0); PG8_STAGE(PG8_SA(1, 1), a1 + hstep, voffA);
            PG8_WAIT_V(8); PG8_WAIT_L(0); PG8_BAR; PG8_MMA(0, 0, At, B0); PG8_MMA(0, 1, At, B1); PG8_BAR; PG8_SCHED;
            PG8_LDA(At, 0, 1); PG8_STAGE(PG8_SB(0, 0), b2, voffB); PG8_STAGE(PG8_SB(0, 1), b2 + hstep, voffB); PG8_STAGE(PG8_SA(0, 0), a2, voffA);
            PG8_WAIT_V(8); PG8_WAIT_L(0); PG8_BAR; PG8_MMA(1, 0, At, B0); PG8_MMA(1, 1, At, B1); PG8_BAR; PG8_SCHED;
            PG8_LDB(B0, 1, 0); PG8_LDB(B1, 1, 1); PG8_SCHED; PG8_LDA(At, 1, 0); PG8_STAGE(PG8_SA(0, 1), a2 + hstep, voffA);
            PG8_WAIT_V(8); PG8_WAIT_L(0); PG8_BAR; PG8_MMA(0, 0, At, B0); PG8_MMA(0, 1, At, B1); PG8_BAR; PG8_SCHED;
            PG8_LDA(At, 1, 1); PG8_STAGE(PG8_SB(1, 0), b3, voffB); PG8_STAGE(PG8_SB(1, 1), b3 + hstep, voffB); PG8_STAGE(PG8_SA(1, 0), a3, voffA);
            PG8_WAIT_V(8); PG8_WAIT_L(0); PG8_BAR; PG8_MMA(1, 0, At, B0); PG8_MMA(1, 1, At, B1); PG8_BAR; PG8_SCHED;
            } else {
            PG8_LDB(B0, 0, 0); PG8_SCHED; PG8_LDA(At, 0, 0); PG8_STAGE(PG8_SA(1, 1), a1 + hstep, voffA);
            PG8_WAIT_L(8); PG8_BAR; PG8_WAIT_L(0); PG8_MMA(0, 0, At, B0); PG8_BAR; PG8_SCHED;
            PG8_LDB(B1, 0, 1); PG8_STAGE(PG8_SB(0, 0), b2, voffB);
            PG8_BAR; PG8_WAIT_L(0); PG8_MMA(0, 1, At, B1); PG8_BAR;
            PG8_LDA(At, 0, 1); PG8_STAGE(PG8_SA(0, 0), a2, voffA);
            PG8_BAR; PG8_WAIT_L(0); PG8_MMA(1, 0, At, B0); PG8_BAR; PG8_SCHED;
            PG8_STAGE(PG8_SB(0, 1), b2 + hstep, voffB);
            PG8_WAIT_V(6); PG8_BAR; PG8_MMA(1, 1, At, B1); PG8_BAR;
            PG8_LDB(B0, 1, 0); PG8_SCHED; PG8_LDA(At, 1, 0); PG8_STAGE(PG8_SA(0, 1), a2 + hstep, voffA);
            PG8_WAIT_L(8); PG8_BAR; PG8_WAIT_L(0); PG8_MMA(0, 0, At, B0); PG8_BAR; PG8_SCHED;
            PG8_LDB(B1, 1, 1); PG8_STAGE(PG8_SB(1, 0), b3, voffB);
            PG8_BAR; PG8_WAIT_L(0); PG8_MMA(0, 1, At, B1); PG8_BAR;
            PG8_LDA(At, 1, 1); PG8_STAGE(PG8_SA(1, 0), a3, voffA);
            PG8_BAR; PG8_WAIT_L(0); PG8_MMA(1, 0, At, B0); PG8_BAR; PG8_SCHED;
            PG8_STAGE(PG8_SB(1, 1), b3 + hstep, voffB);
            PG8_WAIT_V(6); PG8_BAR; PG8_MMA(1, 1, At, B1); PG8_BAR;
            }
        }
        if constexpr (ALIGN_EPI) { if (wr == 0) PG8_BAR; }
        if constexpr (!Epi::AFTER_DRAIN) { E(acc, cur, wr, wc, fr, fq); S.done(cur); }
        if (!has_next) break;
#pragma unroll
        for (int a = 0; a < 2; ++a)
#pragma unroll
            for (int b = 0; b < 2; ++b)
#pragma unroll
                for (int m = 0; m < 4; ++m)
#pragma unroll
                    for (int n = 0; n < 2; ++n) acc[a][b][m][n] = (f32x4){0.f, 0.f, 0.f, 0.f};
        cur = nxt; cA = nA; cB = nB; ++ui;
        if constexpr (ALIGN_EPI) { if (wr == 1) PG8_BAR; }
    }
    PG8_WAIT_V(0);
    if constexpr (!ALIGN_EPI) { if (wr == 0) PG8_BAR; }
    PG8_BAR;
    if constexpr (Epi::AFTER_DRAIN) { E.fused(acc, cur, wr, wc, fr, fq, lds, wid, lane); S.done(cur); }
#undef PG8_SA
#undef PG8_SB
#undef PG8_STAGE
#undef PG8_LDA
#undef PG8_LDB
#undef PG8_MMA
#undef PG8_WAIT_V
#undef PG8_WAIT_L
#undef PG8_BAR
#undef PG8_SCHED
}
}
constexpr int NWAVES = 8;
#ifndef MK_N_LAUNCHES
#define MK_N_LAUNCHES 1
#endif
constexpr int N_LAUNCHES = MK_N_LAUNCHES;
constexpr int NPH = 8;
constexpr int D = 1024, BATCH = 2, SEQ = 8192, M = BATCH * SEQ, DIN = 2560, DEPTH = 2;
constexpr int C_UPOOL = 0, C_GPOOL = 256, C_CA = 512, C_CB = 768, C_GCONV = 1024, C_Q = 1280, C_K = 1792, C_V = 1920, C_GATTN = 2048;
constexpr float EPS = 1e-6f;
constexpr size_t MiB = 1u << 20;
constexpr size_t WS_CTL = 0, CTL_ZERO_BYTES = 1 * MiB;
constexpr size_t WS_WIN = 2 * MiB;
constexpr size_t WS_WOUT = 12 * MiB;
constexpr size_t WS_WPW = 16 * MiB;
constexpr size_t WS_WPOOL = 16 * MiB + 512 * 1024;
constexpr size_t WS_SSP = 17 * MiB;
constexpr size_t WS_XB = 32 * MiB;
constexpr size_t WS_PROJ = 64 * MiB;
constexpr size_t WS_Y = 144 * MiB;
constexpr size_t WS_END = 176 * MiB;
constexpr int CW_BAR = 4096;
constexpr int RING_OFF = 0, RING_BYTES = 131072, LDSCTL_OFF = 146432, MISC_OFF = LDSCTL_OFF + 320, LDS_BYTES = 147456;
#define GAS __attribute__((address_space(1)))
#define LAS __attribute__((address_space(3)))
typedef unsigned short bf16;
typedef unsigned v4u __attribute__((ext_vector_type(4)));
typedef float f32x4 __attribute__((ext_vector_type(4)));
typedef short bf16x8 __attribute__((ext_vector_type(8)));
typedef GAS unsigned gu32;
typedef GAS unsigned long long gu64;
#define RLX_AGENT __ATOMIC_RELAXED, __HIP_MEMORY_SCOPE_AGENT
#define LDS_WAIT() asm volatile("s_waitcnt lgkmcnt(0)" ::: "memory")
#define VM_WAIT() asm volatile("s_waitcnt vmcnt(0)" ::: "memory")
__device__ __forceinline__ unsigned long long rt() { return __builtin_amdgcn_s_memrealtime(); }
__device__ __forceinline__ unsigned f2bf(float f) { unsigned u = __builtin_bit_cast(unsigned, f); return (u + 0x7fffu + ((u >> 16) & 1u)) >> 16; }
__device__ __forceinline__ unsigned pk2(float lo, float hi) { return f2bf(lo) | (f2bf(hi) << 16); }
#define XB_TMO      128
#define XB_XCNT(j)  (256  + 64 * (j))
#define XB_XSUB(j)  (1280 + 64 * (j))
#define XB_XGEN(j)  (2304 + 64 * (j))
#define XB_TOP      3328
#define XB_TOPGEN   3392
#define XCD_BAR_WORDS 3456
#define XB_SPIN_CAP (1u << 18)

__device__ __forceinline__ unsigned xb_ld(unsigned* p)              { return __hip_atomic_load(p, __ATOMIC_RELAXED, __HIP_MEMORY_SCOPE_AGENT); }
__device__ __forceinline__ unsigned xb_add(unsigned* p, unsigned v) { return __hip_atomic_fetch_add(p, v, __ATOMIC_RELAXED, __HIP_MEMORY_SCOPE_AGENT); }
__device__ __forceinline__ unsigned xb_xcc_id() { return (unsigned)__builtin_amdgcn_s_getreg((3 << 11) | 20) & 0xFu; }
#define XB_SPIN(cond, bar) do { unsigned _sp = 0; while (cond) { __builtin_amdgcn_s_sleep(1); \
    if ((++_sp & 255u) == 0u) { if (xb_ld(&(bar)[XB_TMO])) break; if (_sp > XB_SPIN_CAP) { atomicAdd(&(bar)[XB_TMO], 1u); break; } } } } while (0)

struct XcdBarrier {
    unsigned* bar; unsigned x;
    volatile LAS unsigned* st;
};

__device__ __forceinline__ XcdBarrier xcd_barrier_post(unsigned* bar, volatile LAS unsigned* st) {
    XcdBarrier b; b.bar = bar; b.x = xb_xcc_id(); b.st = st;
    if (threadIdx.x == 0) (void)xb_add(&bar[XB_XCNT(b.x)], 1u);
    return b;
}
__device__ __forceinline__ void xcd_barrier_complete(unsigned* bar, unsigned x, unsigned& nloc, unsigned& nx) {
    const unsigned G = gridDim.x * gridDim.y * gridDim.z;
    unsigned sum, cnt, mine, sp = 0u;
    for (;;) {
        sum = 0u; cnt = 0u; mine = 0u;
#pragma unroll
        for (unsigned j = 0; j < 16; ++j) { const unsigned c = xb_ld(&bar[XB_XCNT(j)]); sum += c; cnt += (c > 0u) ? 1u : 0u; mine = (j == x) ? c : mine; }
        if (sum == G) break;
        __builtin_amdgcn_s_sleep(1);
        if ((++sp & 255u) == 0u) { if (xb_ld(&bar[XB_TMO])) break; if (sp > XB_SPIN_CAP) { atomicAdd(&bar[XB_TMO], 1u); break; } }
    }
    nloc = mine > 0u ? mine : 1u; nx = cnt > 0u ? cnt : 1u;
}

__device__ __forceinline__ void xcd_barrier(const XcdBarrier& b) {
    asm volatile("s_waitcnt vmcnt(0)" ::: "memory");
    __syncthreads();
    if (threadIdx.x == 0) {
        unsigned* bar = b.bar;
        __builtin_amdgcn_s_waitcnt(0);
        unsigned nloc = b.st[0], nx = b.st[1];
        if (nloc == 0u) { xcd_barrier_complete(bar, b.x, nloc, nx); b.st[0] = nloc; b.st[1] = nx; }
        const unsigned old = xb_add(&bar[XB_XSUB(b.x)], 1u);
        const unsigned gen = old / nloc;
        if (old + 1u == (gen + 1u) * nloc) {
            __builtin_amdgcn_fence(__ATOMIC_RELEASE, "agent");
            asm volatile("s_waitcnt vmcnt(0)" ::: "memory");
            const unsigned og = xb_add(&bar[XB_TOP], 1u);
            const unsigned tg = og / nx;
            if (og + 1u == (tg + 1u) * nx) xb_add(&bar[XB_TOPGEN], 1u);
            else XB_SPIN(xb_ld(&bar[XB_TOPGEN]) == tg, bar);
            __builtin_amdgcn_fence(__ATOMIC_ACQUIRE, "agent");
            xb_add(&bar[XB_XGEN(b.x)], 1u);
            asm volatile("s_waitcnt vmcnt(0)" ::: "memory");
        } else {
            XB_SPIN(xb_ld(&bar[XB_XGEN(b.x)]) == gen, bar);
            __builtin_amdgcn_fence(__ATOMIC_ACQUIRE, "agent");
            asm volatile("s_waitcnt vmcnt(0)" ::: "memory");
        }
    }
    __syncthreads();
}
typedef float f32x16 __attribute__((ext_vector_type(16)));
typedef short s16x4 __attribute__((ext_vector_type(4)));
typedef float f32x2_t __attribute__((ext_vector_type(2)));
typedef __bf16 bf16x2_t __attribute__((ext_vector_type(2)));
#define MFMA32(a, b, c) __builtin_amdgcn_mfma_f32_32x32x16_bf16((a), (b), (c), 0, 0, 0)
__device__ __forceinline__ int crow(int r, int hi) { return (r & 3) + 8 * (r >> 2) + 4 * hi; }
__device__ __forceinline__ unsigned cvtpk(float lo, float hi) { f32x2_t v = {lo, hi}; bf16x2_t b = __builtin_convertvector(v, bf16x2_t); return __builtin_bit_cast(unsigned, b); }
__device__ __forceinline__ float bflo(unsigned w) { return __uint_as_float(w << 16); }
__device__ __forceinline__ float bfhi(unsigned w) { return __uint_as_float(w & 0xffff0000u); }
__device__ __forceinline__ float fsilu(float x) { return x * __builtin_amdgcn_rcpf(1.f + __builtin_amdgcn_exp2f(-1.4426950408889634f * x)); }
__device__ __forceinline__ float fsigm(float x) { return __builtin_amdgcn_rcpf(1.f + __builtin_amdgcn_exp2f(-1.4426950408889634f * x)); }
__device__ __forceinline__ bf16x8 packP(const f32x16& p, int s) {
    v4u w; w.x = cvtpk(p[8 * s], p[8 * s + 1]); w.y = cvtpk(p[8 * s + 2], p[8 * s + 3]); w.z = cvtpk(p[8 * s + 4], p[8 * s + 5]); w.w = cvtpk(p[8 * s + 6], p[8 * s + 7]);
    return __builtin_bit_cast(bf16x8, w);
}
constexpr int STG_LD = 36;
constexpr int BL_STG = 0, BL_INVL = 8 * 32 * STG_LD * 4, BL_R1 = BL_INVL + 1024;
constexpr int AST = 528;
constexpr int CV_GLU = BL_R1, CV_HN = BL_R1, CV_OUT = BL_R1 + 62 * 1024;
constexpr int PL_U = BL_R1, PL_DIFF = BL_R1 + 47 * 1024;
constexpr int AT_K = BL_R1, AT_V = BL_R1 + 32768;
static_assert(CV_OUT + 32768 <= 146432 && PL_DIFF + 32 * AST <= 146432 && AT_V + 32768 <= 146432, "mixer LDS map");

__device__ __forceinline__ void tile_out(const f32x16& acc, float colscale, LAS float* stg, const LAS float* rowscale, const bf16* gate, bf16* yp, int lane) {
    const int r32 = lane & 31, hi = lane >> 5;
    v4u gq[2];
#pragma unroll
    for (int it = 0; it < 2; ++it) { const int idx = it * 64 + lane, row = idx >> 2, c8 = (idx & 3) * 8; gq[it] = *(const GAS v4u*)(gate + (size_t)row * DIN + c8); }
#pragma unroll
    for (int reg = 0; reg < 16; ++reg) stg[crow(reg, hi) * STG_LD + r32] = acc[reg] * colscale;
#pragma unroll
    for (int it = 0; it < 2; ++it) {
        const int idx = it * 64 + lane, row = idx >> 2, c8 = (idx & 3) * 8;
        f32x4 v0 = *(const LAS f32x4*)(stg + row * STG_LD + c8), v1 = *(const LAS f32x4*)(stg + row * STG_LD + c8 + 4);
        if (rowscale) { const float rs = rowscale[row]; v0 = v0 * rs; v1 = v1 * rs; }
        v4u o;
        o.x = cvtpk(v0[0] * fsilu(bflo(gq[it].x)), v0[1] * fsilu(bfhi(gq[it].x)));
        o.y = cvtpk(v0[2] * fsilu(bflo(gq[it].y)), v0[3] * fsilu(bfhi(gq[it].y)));
        o.z = cvtpk(v1[0] * fsilu(bflo(gq[it].z)), v1[1] * fsilu(bfhi(gq[it].z)));
        o.w = cvtpk(v1[2] * fsilu(bflo(gq[it].w)), v1[3] * fsilu(bfhi(gq[it].w)));
        *(GAS v4u*)(yp + (size_t)row * D + c8) = o;
    }
}

struct MixW { const float *pool_scale, *dw, *cb, *lg, *lb, *sinks; const bf16 *wpw, *wpool; };

__device__ __forceinline__ void conv_unit(LAS unsigned char* L, const bf16* PROJ, bf16* Y, const MixW& W, int tok0, int tid, int lane, int wave) {
    LAS float* GLU = (LAS float*)(L + CV_GLU); LAS float* CO = (LAS float*)(L + CV_OUT); LAS unsigned char* HN = L + CV_HN;
    const int t0 = tok0 & (SEQ - 1);
    for (int e = tid; e < 62 * 32; e += 512) {
        const int r = e >> 5, c8 = (e & 31) * 8;
        f32x4 g0 = {0.f, 0.f, 0.f, 0.f}, g1 = g0;
        if (t0 - 30 + r >= 0) {
            const bf16* pr = PROJ + (size_t)(tok0 - 30 + r) * DIN;
            const v4u a = *(const GAS v4u*)(pr + C_CA + c8), b = *(const GAS v4u*)(pr + C_CB + c8);
            g0[0] = bflo(a.x) * fsigm(bflo(b.x)); g0[1] = bfhi(a.x) * fsigm(bfhi(b.x)); g0[2] = bflo(a.y) * fsigm(bflo(b.y)); g0[3] = bfhi(a.y) * fsigm(bfhi(b.y));
            g1[0] = bflo(a.z) * fsigm(bflo(b.z)); g1[1] = bfhi(a.z) * fsigm(bfhi(b.z)); g1[2] = bflo(a.w) * fsigm(bflo(b.w)); g1[3] = bfhi(a.w) * fsigm(bfhi(b.w));
        }
        *(LAS f32x4*)(GLU + r * 256 + c8) = g0; *(LAS f32x4*)(GLU + r * 256 + c8 + 4) = g1;
    }
    __syncthreads();
    {
        const int c = tid & 255, th = tid >> 8;
        float w[31];
#pragma unroll
        for (int j = 0; j < 31; ++j) w[j] = W.dw[j * 256 + c];
        const float bias = W.cb[c];
#pragma unroll
        for (int grp = 0; grp < 2; ++grp) {
            const int o0 = 16 * th + 8 * grp;
            float in[38];
#pragma unroll
            for (int k = 0; k < 38; ++k) in[k] = GLU[(o0 + k) * 256 + c];
#pragma unroll
            for (int o = 0; o < 8; ++o) { float a = bias;
#pragma unroll
                for (int j = 0; j < 31; ++j) a += w[j] * in[o + j];
                CO[(o0 + o) * 256 + c] = a; }
        }
    }
    __syncthreads();
    {
        const int tk = tid >> 4, part = tid & 15;
        f32x4 v[4]; float s = 0.f;
#pragma unroll
        for (int i = 0; i < 4; ++i) { v[i] = *(const LAS f32x4*)(CO + tk * 256 + 64 * i + 4 * part); s += (v[i][0] + v[i][1]) + (v[i][2] + v[i][3]); }
        s += __shfl_xor(s, 1); s += __shfl_xor(s, 2); s += __shfl_xor(s, 4); s += __shfl_xor(s, 8);
        const float mu = s * (1.f / 256.f); float q = 0.f;
#pragma unroll
        for (int i = 0; i < 4; ++i) { v[i] = v[i] - mu; q += (v[i][0] * v[i][0] + v[i][1] * v[i][1]) + (v[i][2] * v[i][2] + v[i][3] * v[i][3]); }
        q += __shfl_xor(q, 1); q += __shfl_xor(q, 2); q += __shfl_xor(q, 4); q += __shfl_xor(q, 8);
        const float rstd = rsqrtf(q * (1.f / 256.f) + EPS);
#pragma unroll
        for (int i = 0; i < 4; ++i) { const int c = 64 * i + 4 * part; const f32x4 gg = *(const GAS f32x4*)(W.lg + c), bb = *(const GAS f32x4*)(W.lb + c);
            const f32x4 y = v[i] * rstd * gg + bb;
            pg8::u32x2 o; o.x = cvtpk(fsilu(y[0]), fsilu(y[1])); o.y = cvtpk(fsilu(y[2]), fsilu(y[3]));
            *(LAS pg8::u32x2*)(HN + tk * AST + c * 2) = o; }
    }
    __syncthreads();
    {
        const int r32 = lane & 31, hi = lane >> 5;
        const bf16* wrow = W.wpw + (size_t)(32 * wave + r32) * 256 + 8 * hi;
        f32x16 acc = {};
#pragma unroll
        for (int s = 0; s < 16; ++s) { const bf16x8 bfr = *(const GAS bf16x8*)(wrow + 16 * s); const bf16x8 a = *(const LAS bf16x8*)(HN + r32 * AST + (16 * s + 8 * hi) * 2); acc = MFMA32(a, bfr, acc); }
        tile_out(acc, 1.f, (LAS float*)(L + BL_STG) + wave * 32 * STG_LD, nullptr, PROJ + (size_t)tok0 * DIN + C_GCONV + 32 * wave, Y + (size_t)tok0 * D + 256 + 32 * wave, lane);
    }
    __syncthreads();
}

__device__ __forceinline__ void pool_unit(LAS unsigned char* L, const bf16* PROJ, bf16* Y, const MixW& W, int tok0, int tid, int lane, int wave) {
    LAS float* U = (LAS float*)(L + PL_U); LAS unsigned char* DF = L + PL_DIFF;
    const int t0 = tok0 & (SEQ - 1);
    for (int e = tid; e < 47 * 32; e += 512) {
        const int r = e >> 5, c8 = (e & 31) * 8;
        f32x4 g0 = {0.f, 0.f, 0.f, 0.f}, g1 = g0;
        if (t0 - 15 + r >= 0) { const v4u a = *(const GAS v4u*)(PROJ + (size_t)(tok0 - 15 + r) * DIN + C_UPOOL + c8);
            g0[0] = bflo(a.x); g0[1] = bfhi(a.x); g0[2] = bflo(a.y); g0[3] = bfhi(a.y); g1[0] = bflo(a.z); g1[1] = bfhi(a.z); g1[2] = bflo(a.w); g1[3] = bfhi(a.w); }
        *(LAS f32x4*)(U + r * 256 + c8) = g0; *(LAS f32x4*)(U + r * 256 + c8 + 4) = g1;
    }
    __syncthreads();
    {
        const int c = tid & 255, th = tid >> 8, g = wave & 3, wnd = 2 << g;
        const int R0 = 16 * th + 15;
        float s = 0.f;
        for (int k = 0; k < wnd; ++k) s += U[(R0 - k) * 256 + c];
#pragma unroll 4
        for (int o = 0; o < 16; ++o) {
            const int tp = t0 + 16 * th + o; const int cnt = (tp + 1 < wnd) ? tp + 1 : wnd;
            const float uv = U[(R0 + o) * 256 + c];
            const float df = s * __builtin_amdgcn_rcpf((float)cnt) - uv;
            *(LAS bf16*)(DF + (16 * th + o) * AST + c * 2) = (bf16)(cvtpk(df, 0.f) & 0xffffu);
            if (o < 15) s += U[(R0 + o + 1) * 256 + c] - U[(R0 + o + 1 - wnd) * 256 + c];
        }
    }
    __syncthreads();
    {
        const int r32 = lane & 31, hi = lane >> 5, g = wave >> 1, db = wave & 1;
        const bf16* wrow = W.wpool + (size_t)g * 4096 + (size_t)(32 * db + r32) * 64 + 8 * hi;
        f32x16 acc = {};
#pragma unroll
        for (int s = 0; s < 4; ++s) { const bf16x8 bfr = *(const GAS bf16x8*)(wrow + 16 * s); const bf16x8 a = *(const LAS bf16x8*)(DF + r32 * AST + (64 * g + 16 * s + 8 * hi) * 2); acc = MFMA32(a, bfr, acc); }
        tile_out(acc, W.pool_scale[32 * wave + r32], (LAS float*)(L + BL_STG) + wave * 32 * STG_LD, nullptr, PROJ + (size_t)tok0 * DIN + C_GPOOL + 32 * wave, Y + (size_t)tok0 * D + 32 * wave, lane);
    }
    __syncthreads();
}

__device__ __forceinline__ void attn_unit(LAS unsigned char* L, const bf16* PROJ, bf16* Y, const MixW& W, int unit, int tid, int lane, int wave) {
    const int n = unit & 63, kvh = (unit >> 6) & 1, b = unit >> 7;
    const int tokq0 = b * SEQ + n * 128;
    LAS unsigned char* KL = L + AT_K; LAS unsigned char* VL = L + AT_V;
    for (int e = tid; e < 256 * 8; e += 512) {
        const int j = e >> 3, ch = e & 7;
        v4u kq = {0u, 0u, 0u, 0u}, vq = kq;
        if (n > 0 || j >= 128) { const bf16* pr = PROJ + (size_t)(tokq0 - 128 + j) * DIN + kvh * 64 + ch * 8; kq = *(const GAS v4u*)(pr + C_K); vq = *(const GAS v4u*)(pr + C_V); }
        *(LAS v4u*)(KL + j * 128 + ((ch ^ (j & 7)) << 4)) = kq;
        *(LAS v4u*)(VL + j * 128 + ((ch ^ (((j >> 1) & 1) << 2)) << 4)) = vq;
    }
    __syncthreads();
    const int r32 = lane & 31, hi = lane >> 5;
    const int hq = kvh * 4 + (wave >> 1);
    const float slope2 = exp2f(-(float)(hq + 1)) * 1.4426950408889634f, sink2 = W.sinks[hq] * 1.4426950408889634f;
    const float c1 = 0.125f * 1.4426950408889634f;
    LAS float* stg = (LAS float*)(L + BL_STG) + wave * 32 * STG_LD;
    LAS float* invl = (LAS float*)(L + BL_INVL) + wave * 32;
#pragma unroll 1
    for (int blk = 0; blk < 2; ++blk) {
        const int i0 = (wave & 1) * 64 + blk * 32, jt0 = i0 >> 5;
        const bf16* qrow = PROJ + (size_t)(tokq0 + i0 + r32) * DIN + C_Q + hq * 64 + 8 * hi;
        bf16x8 qf[4];
#pragma unroll
        for (int s = 0; s < 4; ++s) qf[s] = *(const GAS bf16x8*)(qrow + 16 * s);
        f32x16 p[5];
        float mx = sink2;
#pragma unroll
        for (int d = 0; d < 5; ++d) {
            const int jt = jt0 + d;
            f32x16 a = {};
#pragma unroll
            for (int s = 0; s < 4; ++s) { const int key = 32 * jt + r32; const bf16x8 kf = *(const LAS bf16x8*)(KL + key * 128 + (((2 * s + hi) ^ (key & 7)) << 4)); a = MFMA32(kf, qf[s], a); }
            const bool tile_ok = (n > 0) || (jt >= 4);
            const float distb = (float)(128 + i0 + r32 - 32 * jt - 4 * hi);
#pragma unroll
            for (int reg = 0; reg < 16; ++reg) {
                const float dist = distb - (float)((reg & 3) + 8 * (reg >> 2));
                const float v = a[reg] * c1 - slope2 * dist;
                const bool ok = tile_ok && dist >= 0.f && dist < 128.f;
                a[reg] = ok ? v : -1e30f;
                mx = fmaxf(mx, a[reg]);
            }
            p[d] = a;
        }
        mx = fmaxf(mx, __shfl_xor(mx, 32));
        float lsum = 0.f;
#pragma unroll
        for (int d = 0; d < 5; ++d)
#pragma unroll
            for (int reg = 0; reg < 16; ++reg) { const float e = __builtin_amdgcn_exp2f(p[d][reg] - mx); p[d][reg] = e; lsum += e; }
        lsum += __shfl_xor(lsum, 32);
        lsum += __builtin_amdgcn_exp2f(sink2 - mx);
        if (hi == 0) invl[r32] = __builtin_amdgcn_rcpf(lsum);
        f32x16 o0 = {}, o1 = {};
        const int q4 = (lane & 15) >> 2, p4 = lane & 3, g2 = (lane >> 4) & 1;
#pragma unroll
        for (int d = 0; d < 5; ++d) {
            const int jt = jt0 + d;
#pragma unroll
            for (int s = 0; s < 2; ++s) {
                const bf16x8 pa = packP(p[d], s);
                const int keyA = 32 * jt + 16 * s + 4 * hi + q4, keyB = keyA + 8;
                const int offA = keyA * 128 + 32 * g2 + 8 * p4, offB = keyB * 128 + 32 * g2 + 8 * p4;
                const int swA = ((keyA >> 1) & 1) << 6, swB = ((keyB >> 1) & 1) << 6;
                const s16x4 a0 = __builtin_bit_cast(s16x4, __builtin_amdgcn_ds_read_tr16_b64_v4i16((LAS s16x4*)(VL + (offA ^ swA))));
                const s16x4 b0 = __builtin_bit_cast(s16x4, __builtin_amdgcn_ds_read_tr16_b64_v4i16((LAS s16x4*)(VL + (offB ^ swB))));
                const s16x4 a1 = __builtin_bit_cast(s16x4, __builtin_amdgcn_ds_read_tr16_b64_v4i16((LAS s16x4*)(VL + ((offA + 64) ^ swA))));
                const s16x4 b1 = __builtin_bit_cast(s16x4, __builtin_amdgcn_ds_read_tr16_b64_v4i16((LAS s16x4*)(VL + ((offB + 64) ^ swB))));
                const bf16x8 v0 = {a0[0], a0[1], a0[2], a0[3], b0[0], b0[1], b0[2], b0[3]}, v1 = {a1[0], a1[1], a1[2], a1[3], b1[0], b1[1], b1[2], b1[3]};
                o0 = MFMA32(pa, v0, o0); o1 = MFMA32(pa, v1, o1);
            }
        }
        const bf16* gate = PROJ + (size_t)(tokq0 + i0) * DIN + C_GATTN + hq * 64; bf16* yp = Y + (size_t)(tokq0 + i0) * D + 512 + hq * 64;
        tile_out(o0, 1.f, stg, invl, gate, yp, lane);
        tile_out(o1, 1.f, stg, invl, gate + 32, yp + 32, lane);
    }
    __syncthreads();
}
__device__ __forceinline__ float bf2f(bf16 v) { return __uint_as_float((unsigned)v << 16); }
__device__ __forceinline__ float wave_sum(float v) {
#pragma unroll
    for (int o = 1; o < 64; o <<= 1) v += __shfl_xor(v, o);
    return v;
}
__device__ __forceinline__ float silu_f(float x) { return x / (1.f + __expf(-x)); }
__device__ __forceinline__ float sigmoid_f(float x) { return 1.f / (1.f + __expf(-x)); }

__device__ __forceinline__ void p0_transpose_item(const float* W, int K, int N, bf16* WT, LAS float* scr, int item, int lane, const float* kscale) {
    const int nblk = N / 32, kb = item / nblk, nb = item % nblk, k0 = 64 * kb, n0 = 32 * nb;
#pragma unroll 8
    for (int i = 0; i < 32; ++i) { const int kk = 2 * i + (lane >> 5); float v = W[(size_t)(k0 + kk) * N + n0 + (lane & 31)]; if (kscale) v *= kscale[k0 + kk]; scr[kk * 33 + (lane & 31)] = v; }
    LDS_WAIT(); asm volatile("" ::: "memory");
    const int c = lane & 7;
#pragma unroll
    for (int j = 0; j < 4; ++j) { const int n = (lane >> 3) + 8 * j; const LAS float* s = scr + (8 * c) * 33 + n;
        v4u o; o.x = pk2(s[0 * 33], s[1 * 33]); o.y = pk2(s[2 * 33], s[3 * 33]); o.z = pk2(s[4 * 33], s[5 * 33]); o.w = pk2(s[6 * 33], s[7 * 33]);
        *(GAS v4u*)(WT + (size_t)(n0 + n) * K + k0 + 8 * c) = o; }
    LDS_WAIT(); asm volatile("" ::: "memory");
}

struct Args { const float* in[13]; float* out; unsigned char* ws; int ph_lo, ph_hi; };

__global__ void __launch_bounds__(NWAVES * 64, 2) fwd(Args args) {
    extern __shared__ __attribute__((aligned(16))) unsigned char lds[];
    LAS unsigned char* L = (LAS unsigned char*)lds;
    volatile LAS unsigned* MISC = (volatile LAS unsigned*)(L + MISC_OFF);
    const int tid = threadIdx.x, lane = tid & 63, wave = __builtin_amdgcn_readfirstlane(tid >> 6);
    const int G = gridDim.x;
    unsigned char* ws = args.ws;
    gu32* ctl = (gu32*)(ws + WS_CTL);
    const float* x = args.in[0]; const float* ln_g = args.in[1]; const float* w_in = args.in[2]; const float* pool_w = args.in[3]; const float* pool_scale = args.in[4];
    const float* conv_dw = args.in[5]; const float* conv_b = args.in[6]; const float* conv_ln_g = args.in[7]; const float* conv_ln_b = args.in[8]; const float* conv_pw = args.in[9];
    const float* attn_sinks = args.in[10]; const float* w_out = args.in[11]; const float* final_g = args.in[12];
    float* out = args.out;
    bf16* WIN = (bf16*)(ws + WS_WIN); bf16* WOUT = (bf16*)(ws + WS_WOUT); bf16* WPW = (bf16*)(ws + WS_WPW); bf16* WPOOL = (bf16*)(ws + WS_WPOOL);
    float* SSP = (float*)(ws + WS_SSP); bf16* XB = (bf16*)(ws + WS_XB); bf16* PROJ = (bf16*)(ws + WS_PROJ); bf16* Y = (bf16*)(ws + WS_Y);
    for (int u = tid; u < (LDS_BYTES - LDSCTL_OFF) / 4; u += NWAVES * 64) ((LAS unsigned*)(L + LDSCTL_OFF))[u] = 0u;
    __syncthreads();
    XcdBarrier bar; bar.bar = (unsigned*)(ctl + CW_BAR); bar.x = 0; bar.st = nullptr;
    if (N_LAUNCHES == 1) bar = xcd_barrier_post((unsigned*)(ctl + CW_BAR), MISC + 8);
    const int lo = args.ph_lo, hi = args.ph_hi;
#define IN(k) (lo <= (k) && (k) < hi)
#define SEAM(k) do { if (IN(k) && IN((k) + 1)) xcd_barrier(bar); } while (0)

    if (IN(0)) {
        LAS float* scr = (LAS float*)(L + RING_OFF + wave * 16384);
        const int gw = blockIdx.x * NWAVES + wave, NGW = G * NWAVES;
        constexpr int I_IN = (D / 64) * (DIN / 32), I_OUT = (D / 64) * (D / 32), I_PW = (256 / 64) * (256 / 32), I_PL = 2;
        constexpr int NITEMS = DEPTH * (I_IN + I_OUT + I_PW + 4 * I_PL);
        for (int it = gw; it < NITEMS; it += NGW) {
            int r = it;
            if (r < DEPTH * I_IN) { const int l = r / I_IN; p0_transpose_item(w_in + (size_t)l * D * DIN, D, DIN, WIN + (size_t)l * DIN * D, scr, r % I_IN, lane, ln_g + l * D); continue; } r -= DEPTH * I_IN;
            if (r < DEPTH * I_OUT) { const int l = r / I_OUT; p0_transpose_item(w_out + (size_t)l * D * D, D, D, WOUT + (size_t)l * D * D, scr, r % I_OUT, lane, nullptr); continue; } r -= DEPTH * I_OUT;
            if (r < DEPTH * I_PW) { const int l = r / I_PW; p0_transpose_item(conv_pw + (size_t)l * 65536, 256, 256, WPW + (size_t)l * 65536, scr, r % I_PW, lane, nullptr); continue; } r -= DEPTH * I_PW;
            { const int lg = r / I_PL; p0_transpose_item(pool_w + (size_t)lg * 4096, 64, 64, WPOOL + (size_t)lg * 4096, scr, r % I_PL, lane, nullptr); }
        }
        for (int m = gw; m < M; m += NGW) {
            const GAS f32x4* xr = (const GAS f32x4*)(x + (size_t)m * D) + lane;
            f32x4 v[4]; float s = 0.f;
#pragma unroll
            for (int j = 0; j < 4; ++j) { v[j] = xr[64 * j]; s += (v[j].x * v[j].x + v[j].y * v[j].y) + (v[j].z * v[j].z + v[j].w * v[j].w); }
            s = wave_sum(s);
            GAS unsigned long long* o8 = (GAS unsigned long long*)(XB + (size_t)m * D) + lane;
#pragma unroll
            for (int j = 0; j < 4; ++j) o8[64 * j] = (unsigned long long)pk2(v[j].x, v[j].y) | ((unsigned long long)pk2(v[j].z, v[j].w) << 32);
            if (lane == 0) *(f32x4*)(SSP + (size_t)m * 4) = (f32x4){s, 0.f, 0.f, 0.f};
        }
    }
    SEAM(0);
    for (int l = 0; l < DEPTH; ++l) {
        const int pb = 1 + 3 * l;
        if (IN(pb)) {
            pg8::Gemm g{XB, WIN + (size_t)l * DIN * D, M, DIN, D}; pg8::StaticOrder S; S.init(M, DIN, G, (int)blockIdx.x);
            pg8::EpiProj E{PROJ, DIN, SSP + (size_t)l * M * 4};
            pg8::gemm_phase<pg8::EpiProj, pg8::StaticOrder, true, true>(L + RING_OFF, g, S, E);
        }
        SEAM(pb);
        if (IN(pb + 1)) {
            int tid = threadIdx.x; asm volatile("" : "+v"(tid));
            const int lane = tid & 63;
            MixW W{pool_scale + l * 256, conv_dw + l * 31 * 256, conv_b + l * 256, conv_ln_g + l * 256, conv_ln_b + l * 256, attn_sinks + l * 8, WPW + (size_t)l * 65536, WPOOL + (size_t)l * 16384};
            for (int u = blockIdx.x; u < 256; u += G) attn_unit(L, PROJ, Y, W, u, tid, lane, wave);
            for (int u = blockIdx.x; u < 512; u += G) conv_unit(L, PROJ, Y, W, 32 * u, tid, lane, wave);
            for (int u = blockIdx.x; u < 512; u += G) pool_unit(L, PROJ, Y, W, 32 * u, tid, lane, wave);
        }
        SEAM(pb + 1);
        if (IN(pb + 2)) {
            pg8::Gemm g{Y, WOUT + (size_t)l * D * D, M, D, D}; pg8::StaticOrder S; S.init(M, D, G, (int)blockIdx.x);
            pg8::EpiRes E{l == 0 ? x : out, out, XB, SSP + (size_t)(l + 1) * M * 4, D};
            pg8::gemm_phase<pg8::EpiRes, pg8::StaticOrder, false, true>(L + RING_OFF, g, S, E);
        }
        SEAM(pb + 2);
    }
    if (IN(7)) {
        const int gw = blockIdx.x * NWAVES + wave, NGW = G * NWAVES;
        for (int m = gw; m < M; m += NGW) {
            GAS f32x4* xr = (GAS f32x4*)(out + (size_t)m * D) + lane;
            f32x4 v[4]; float s = 0.f;
#pragma unroll
            for (int j = 0; j < 4; ++j) { v[j] = xr[64 * j]; s += (v[j].x * v[j].x + v[j].y * v[j].y) + (v[j].z * v[j].z + v[j].w * v[j].w); }
            s = wave_sum(s);
            const float rs = rsqrtf(s * (1.f / D) + EPS);
#pragma unroll
            for (int j = 0; j < 4; ++j) { const f32x4 gg = ((const GAS f32x4*)final_g)[lane + 64 * j]; xr[64 * j] = v[j] * rs * gg; }
        }
    }
#undef IN
#undef SEAM
}

extern "C" void kernel_launch(void* const* d_in, const int* in_sizes, int n_in, void* d_out, int out_size, void* d_ws, size_t ws_size, hipStream_t stream) {
    static int grid = 0;
    if (grid == 0) {
        if (n_in != 13 || in_sizes[0] != M * D || out_size != M * D || ws_size < WS_END) { fprintf(stderr, "kernel_launch: unexpected shapes (n_in %d in0 %d out %d ws %zu)\n", n_in, n_in > 0 ? in_sizes[0] : -1, out_size, ws_size); grid = -1; return; }
        int dev = 0, cus = 0, per_cu = 0;
        if (hipGetDevice(&dev) != hipSuccess || hipDeviceGetAttribute(&cus, hipDeviceAttributeMultiprocessorCount, dev) != hipSuccess) { grid = -1; return; }
        if (hipFuncSetAttribute((const void*)fwd, hipFuncAttributeMaxDynamicSharedMemorySize, LDS_BYTES) != hipSuccess) { fprintf(stderr, "kernel_launch: hipFuncSetAttribute failed\n"); grid = -1; return; }
        if (hipOccupancyMaxActiveBlocksPerMultiprocessor(&per_cu, (const void*)fwd, NWAVES * 64, LDS_BYTES) != hipSuccess || per_cu < 1) { fprintf(stderr, "kernel_launch: occupancy query says %d blocks/CU\n", per_cu); }
        (void)hipGetLastError();
        if (cus != 256) { fprintf(stderr, "kernel_launch: built for a 256-CU device, found %d\n", cus); grid = -1; return; }
        grid = cus;
    }
    if (grid < 0) return;
    if (hipMemsetAsync((char*)d_ws + WS_CTL, 0, CTL_ZERO_BYTES, stream) != hipSuccess) return;
    Args a{};
    for (int i = 0; i < 13; ++i) a.in[i] = (const float*)d_in[i];
    a.out = (float*)d_out; a.ws = (unsigned char*)d_ws;
    for (int li = 0; li < N_LAUNCHES; ++li) {
        a.ph_lo = (N_LAUNCHES == 1) ? 0 : li; a.ph_hi = (N_LAUNCHES == 1) ? NPH : li + 1;
        hipLaunchKernelGGL(fwd, dim3(grid), dim3(NWAVES * 64), LDS_BYTES, stream, a);
    }
}
```

```cpp
#include <hip/hip_runtime.h>
#include <cstdio>
#include <cstdint>
namespace pg8 {
#define PG8_LAS __attribute__((address_space(3)))
typedef unsigned short bf16_t;
typedef short bf16x8 __attribute__((ext_vector_type(8)));
typedef float f32x4 __attribute__((ext_vector_type(4)));
typedef unsigned u32x4 __attribute__((ext_vector_type(4)));
constexpr int BM = 256, BK = 64, HALF = 128, HTB = HALF * BK * 2  , STAGE_BYTES = 8 * HTB, NXCD = 8, WGM = 8;

__host__ __device__ __forceinline__ int lds_byte(int r, int c) { const int st = (r >> 4) * 2 + (c >> 5), rr = r & 15, cc = c & 31, ob = rr * 64 + cc * 2; return st * 1024 + (ob ^ (((ob >> 9) & 1) << 5)); }
__host__ __device__ __forceinline__ void stage_rc(int b, int& R, int& C) { const int st = b / 1024, sb = b % 1024, swz = sb ^ (((sb >> 9) & 1) << 5); R = (st >> 1) * 16 + swz / 64; C = (st & 1) * 32 + (swz % 64) / 2; }
__host__ __device__ __forceinline__ int perm32(int rho) { const int n = rho >> 4, i = rho & 15; return 8 * (i >> 2) + 4 * n + (i & 3); }

struct Unit { int pm, pn; };
struct Gemm { const bf16_t* A; const bf16_t* Bt; int M, N, K; };

struct StaticOrder {
    int nM, nN, nwg, G, c;
    __host__ __device__ void init(int M, int N, int G_, int c_) { nM = M / BM; nN = N / BM; nwg = nM * nN; G = G_; c = c_; }
    __host__ __device__ bool next(int i, Unit& u) const {
        const long L = (long)i * G + c; if (L >= nwg) return false;
        int wgid = (int)L; { const int q = nwg / NXCD, r = nwg % NXCD, xcd = wgid % NXCD, off = wgid / NXCD; wgid = (xcd < r ? xcd * (q + 1) : r * (q + 1) + (xcd - r) * q) + off; }
        const int nig = WGM * nN, gid = wgid / nig, fm = gid * WGM, gsz = (nM - fm) < WGM ? (nM - fm) : WGM;
        u.pm = fm + ((wgid % nig) % gsz); u.pn = (wgid % nig) / gsz; return true;
    }
    __device__ __forceinline__ void a_ready(const Unit&) const {}
    __device__ __forceinline__ void done(const Unit&) const {}
};

__device__ __forceinline__ unsigned cvt_pk_bf16(float lo, float hi) { unsigned r; asm volatile("v_cvt_pk_bf16_f32 %0, %1, %2" : "=v"(r) : "v"(lo), "v"(hi)); return r; }
typedef float f32x2 __attribute__((ext_vector_type(2)));
typedef unsigned u32x2 __attribute__((ext_vector_type(2)));
struct EpiProj {
    static constexpr bool PERM = true, AFTER_DRAIN = false;
    bf16_t* O; int ldc; const float* ssp;
    __device__ __forceinline__ void operator()(const f32x4 (&acc)[2][2][4][2], const Unit& u, int wr, int wc, int fr, int fq) const {
        const int row0 = u.pm * BM + wr * 64 + fr, col0 = u.pn * BM + wc * 32 + 8 * fq;
#pragma unroll
        for (int ai = 0; ai < 2; ++ai)
#pragma unroll
            for (int m = 0; m < 4; ++m) {
                const int row = row0 + ai * HALF + m * 16;
                const f32x4 s = *(const f32x4*)(ssp + (size_t)row * 4);
                const float rs = rsqrtf(((s[0] + s[1]) + (s[2] + s[3])) * (1.0f / 1024.0f) + 1e-6f);
                bf16_t* rowp = O + (size_t)row * ldc + col0;
#pragma unroll
                for (int bj = 0; bj < 2; ++bj) { const f32x4 v0 = acc[ai][bj][m][0] * rs, v1 = acc[ai][bj][m][1] * rs;
                    u32x4 w; w.x = cvt_pk_bf16(v0[0], v0[1]); w.y = cvt_pk_bf16(v0[2], v0[3]); w.z = cvt_pk_bf16(v1[0], v1[1]); w.w = cvt_pk_bf16(v1[2], v1[3]);
                    *(u32x4*)(rowp + bj * HALF) = w; }
            }
    }
};
struct EpiRes {
    static constexpr bool PERM = false, AFTER_DRAIN = true;
    const float* basef; bf16_t* xb; float* ssp; int ldc; int base_bf16;
    __device__ __forceinline__ void fused(f32x4 (&acc)[2][2][4][2], const Unit& u, int wr, int wc, int fr, int fq, PG8_LAS unsigned char* lds, int wid, int lane) const {
        PG8_LAS float* P = (PG8_LAS float*)lds;
        const int col0 = u.pn * BM + wc * 32 + 4 * fq;
#pragma unroll
        for (int ai = 0; ai < 2; ++ai)
#pragma unroll
            for (int m = 0; m < 4; ++m) { const int r = ai * HALF + wr * 64 + m * 16 + fr; const size_t off = (size_t)(u.pm * BM + r) * ldc + col0; float s = 0.f;
                f32x4 bs[2][2];
                if (base_bf16) {
#pragma unroll
                    for (int bj = 0; bj < 2; ++bj)
#pragma unroll
                        for (int n = 0; n < 2; ++n) { const u32x2 w = *(const u32x2*)(xb + off + bj * HALF + n * 16);
                            bs[bj][n] = (f32x4){__uint_as_float(w.x << 16), __uint_as_float(w.x & 0xffff0000u), __uint_as_float(w.y << 16), __uint_as_float(w.y & 0xffff0000u)}; }
                } else {
#pragma unroll
                    for (int bj = 0; bj < 2; ++bj)
#pragma unroll
                        for (int n = 0; n < 2; ++n) bs[bj][n] = *(const f32x4*)(basef + off + bj * HALF + n * 16);
                }
#pragma unroll
                for (int bj = 0; bj < 2; ++bj)
#pragma unroll
                    for (int n = 0; n < 2; ++n) { const f32x4 o = bs[bj][n] + acc[ai][bj][m][n];
                        u32x2 w; w.x = cvt_pk_bf16(o[0], o[1]); w.y = cvt_pk_bf16(o[2], o[3]); *(u32x2*)(xb + off + bj * HALF + n * 16) = w;
                        s += (o[0] * o[0] + o[1] * o[1]) + (o[2] * o[2] + o[3] * o[3]); }
                s += __shfl_xor(s, 16); s += __shfl_xor(s, 32);
                if (fq == 0) P[r * 4 + wc] = s;
                if (m & 1) asm volatile("" ::: "memory"); }
        asm volatile("s_waitcnt lgkmcnt(0)" ::: "memory"); __builtin_amdgcn_s_barrier(); asm volatile("" ::: "memory");
        const int tid = wid * 64 + lane;
        if (tid < 256) { const f32x4 p = *(const PG8_LAS f32x4*)(P + tid * 4); ssp[(size_t)(u.pm * BM + tid) * 4 + u.pn] = (p[0] + p[1]) + (p[2] + p[3]); }
        asm volatile("s_waitcnt lgkmcnt(0)" ::: "memory"); __builtin_amdgcn_s_barrier(); asm volatile("" ::: "memory");
    }
};
template <class Epi, class Sched, bool ALIGN_EPI = false, bool SP2 = false>
__device__ __forceinline__ void gemm_phase(PG8_LAS unsigned char* lds, const Gemm g, const Sched& S, const Epi& E) {
    int tid_ = threadIdx.x; asm volatile("" : "+v"(tid_));
    const int tid = tid_, wid = __builtin_amdgcn_readfirstlane(tid >> 6), lane = tid & 63, wr = wid >> 2, wc = wid & 3, fr = lane & 15, fq = lane >> 4;
    const int K = g.K, nt = K / BK;
    unsigned voffA[2], voffB[2];
#pragma unroll
    for (int i = 0; i < 2; ++i) { int R, C; stage_rc(tid * 16 + i * 8192, R, C); const int Rb = Epi::PERM ? ((R & ~31) + perm32(R & 31)) : R;
        voffA[i] = (unsigned)(R * K + C) * 2u; voffB[i] = (unsigned)(Rb * K + C) * 2u; }
    const size_t kstep = (size_t)(BK * 2);
    const size_t hstep = (size_t)HALF * K * 2;
    const size_t tstep = 2 * hstep;
    const unsigned ldsw = (unsigned)wid * 1024u;
    const int aoff = lds_byte(wr * 64 + fr, fq * 8), boff = lds_byte(wc * 32 + fr, fq * 8);
#define PG8_SA(b, h) (((b) * 2 + (h)) * HTB)
#define PG8_SB(b, h) ((4 + (b) * 2 + (h)) * HTB)
#define PG8_STAGE(bufoff, gbase, voff) do { _Pragma("unroll") for (int _i = 0; _i < 2; ++_i) \
        __builtin_amdgcn_global_load_lds((const unsigned*)((const char*)(gbase) + (voff)[_i]), (PG8_LAS unsigned*)(lds + (bufoff) + ldsw + _i * 8192), 16, 0, 0); } while (0)
#define PG8_LDA(dst, b, h) do { _Pragma("unroll") for (int m = 0; m < 4; ++m) _Pragma("unroll") for (int k = 0; k < 2; ++k) dst[m][k] = *(const PG8_LAS bf16x8*)(lds + PG8_SA(b, h) + aoff + m * 2048 + k * 1024); } while (0)
#define PG8_LDB(dst, b, h) do { _Pragma("unroll") for (int n = 0; n < 2; ++n) _Pragma("unroll") for (int k = 0; k < 2; ++k) dst[n][k] = *(const PG8_LAS bf16x8*)(lds + PG8_SB(b, h) + boff + n * 2048 + k * 1024); } while (0)
#define PG8_MMA(ai, bj, At, Bt) do { __builtin_amdgcn_s_setprio(1); _Pragma("unroll") for (int m = 0; m < 4; ++m) _Pragma("unroll") for (int n = 0; n < 2; ++n) _Pragma("unroll") for (int k = 0; k < 2; ++k) \
        acc[ai][bj][m][n] = __builtin_amdgcn_mfma_f32_16x16x32_bf16(Bt[n][k], At[m][k], acc[ai][bj][m][n], 0, 0, 0); __builtin_amdgcn_s_setprio(0); } while (0)
#define PG8_WAIT_V(n) asm volatile("s_waitcnt vmcnt(" #n ")" ::: "memory")
#define PG8_WAIT_L(n) asm volatile("s_waitcnt lgkmcnt(" #n ")" ::: "memory")
#define PG8_BAR __builtin_amdgcn_s_barrier()
#define PG8_SCHED __builtin_amdgcn_sched_barrier(0)
    Unit cur, nxt; int ui = 0;
    if (!S.next(0, cur)) return;
    f32x4 acc[2][2][4][2];
#pragma unroll
    for (int a = 0; a < 2; ++a)
#pragma unroll
        for (int b = 0; b < 2; ++b)
#pragma unroll
            for (int m = 0; m < 4; ++m)
#pragma unroll
                for (int n = 0; n < 2; ++n) acc[a][b][m][n] = (f32x4){0.f, 0.f, 0.f, 0.f};
    bf16x8 At[4][2], B0[2][2], B1[2][2];
    const char* cA = (const char*)g.A + (size_t)cur.pm * tstep; const char* cB = (const char*)g.Bt + (size_t)cur.pn * tstep;
    S.a_ready(cur);
    if constexpr (SP2) {
        PG8_STAGE(PG8_SB(0, 0), cB, voffB); PG8_STAGE(PG8_SB(0, 1), cB + hstep, voffB); PG8_STAGE(PG8_SA(0, 0), cA, voffA); PG8_STAGE(PG8_SA(0, 1), cA + hstep, voffA);
        if (wr == 1) PG8_BAR;
        PG8_WAIT_V(2); PG8_BAR;
        PG8_STAGE(PG8_SB(1, 0), cB + kstep, voffB); PG8_STAGE(PG8_SA(1, 0), cA + kstep, voffA); PG8_STAGE(PG8_SB(1, 1), cB + hstep + kstep, voffB);
        PG8_WAIT_V(6); PG8_BAR;
    } else {
        PG8_STAGE(PG8_SB(0, 0), cB, voffB); PG8_STAGE(PG8_SA(0, 0), cA, voffA); PG8_STAGE(PG8_SB(0, 1), cB + hstep, voffB); PG8_STAGE(PG8_SA(0, 1), cA + hstep, voffA);
        if (wr == 1) PG8_BAR;
        PG8_WAIT_V(4); PG8_BAR;
        PG8_STAGE(PG8_SB(1, 0), cB + kstep, voffB); PG8_STAGE(PG8_SA(1, 0), cA + kstep, voffA); PG8_STAGE(PG8_SB(1, 1), cB + hstep + kstep, voffB);
        PG8_WAIT_V(6); PG8_BAR;
    }
    for (;;) {
        const bool has_next = S.next(ui + 1, nxt);
        const char* nA = has_next ? (const char*)g.A + (size_t)nxt.pm * tstep : cA; const char* nB = has_next ? (const char*)g.Bt + (size_t)nxt.pn * tstep : cB;
        for (int t = 0; t < nt; t += 2) {
            const bool last = (t == nt - 2);
            const char* a1 = cA + (size_t)(t + 1) * kstep;
            const char* a2 = last ? nA : cA + (size_t)(t + 2) * kstep; const char* b2 = last ? nB : cB + (size_t)(t + 2) * kstep;
            const char* a3 = a2 + kstep; const char* b3 = b2 + kstep;
            if (last && has_next) S.a_ready(nxt);
            if constexpr (SP2) {
            PG8_LDB(B0, 0, 0); PG8_LDB(B1, 0, 1); PG8_SCHED; PG8_LDA(At, 0, 0); PG8_STAGE(PG8_SA(1, 1), a1 + hstep, voffA);
            PG8_WAIT_V(8); PG8_WAIT_L(0); PG8_BAR; PG8_MMA(0, 0, At, B0); PG8_MMA(0, 1, At, B1); PG8_BAR; PG8_SCHED;
            PG8_LDA(At, 0, 1); PG8_STAGE(PG8_SB(0, 0), b2, voffB); PG8_STAGE(PG8_SB(0, 1), b2 + hstep, voffB); PG8_STAGE(PG8_SA(0, 0), a2, voffA);
            PG8_WAIT_V(8); PG8_WAIT_L(0); PG8_BAR; PG8_MMA(1, 0, At, B0); PG8_MMA(1, 1, At, B1); PG8_BAR; PG8_SCHED;
            PG8_LDB(B0, 1, 0); PG8_LDB(B1, 1, 1); PG8_SCHED; PG8_LDA(At, 1, 0); PG8_STAGE(PG8_SA(0, 1), a2 + hstep, voffA);
            PG8_WAIT_V(8); PG8_WAIT_L(0); PG8_BAR; PG8_MMA(0, 0, At, B0); PG8_MMA(0, 1, At, B1); PG8_BAR; PG8_SCHED;
            PG8_LDA(At, 1, 1); PG8_STAGE(PG8_SB(1, 0), b3, voffB); PG8_STAGE(PG8_SB(1, 1), b3 + hstep, voffB); PG8_STAGE(PG8_SA(1, 0), a3, voffA);
            PG8_WAIT_V(8); PG8_WAIT_L(0); PG8_BAR; PG8_MMA(1, 0, At, B0); PG8_MMA(1, 1, At, B1); PG8_BAR; PG8_SCHED;
            } else {
            PG8_LDB(B0, 0, 0); PG8_SCHED; PG8_LDA(At, 0, 0); PG8_STAGE(PG8_SA(1, 1), a1 + hstep, voffA);
            PG8_WAIT_L(8); PG8_BAR; PG8_WAIT_L(0); PG8_MMA(0, 0, At, B0); PG8_BAR; PG8_SCHED;
            PG8_LDB(B1, 0, 1); PG8_STAGE(PG8_SB(0, 0), b2, voffB);
            PG8_BAR; PG8_WAIT_L(0); PG8_MMA(0, 1, At, B1); PG8_BAR;
            PG8_LDA(At, 0, 1); PG8_STAGE(PG8_SA(0, 0), a2, voffA);
            PG8_BAR; PG8_WAIT_L(0); PG8_MMA(1, 0, At, B0); PG8_BAR; PG8_SCHED;
            PG8_STAGE(PG8_SB(0, 1), b2 + hstep, voffB);
            PG8_WAIT_V(6); PG8_BAR; PG8_MMA(1, 1, At, B1); PG8_BAR;
            PG8_LDB(B0, 1, 0); PG8_SCHED; PG8_LDA(At, 1, 0); PG8_STAGE(PG8_SA(0, 1), a2 + hstep, voffA);
            PG8_WAIT_L(8); PG8_BAR; PG8_WAIT_L(0); PG8_MMA(0, 0, At, B0); PG8_BAR; PG8_SCHED;
            PG8_LDB(B1, 1, 1); PG8_STAGE(PG8_SB(1, 0), b3, voffB);
            PG8_BAR; PG8_WAIT_L(0); PG8_MMA(0, 1, At, B1); PG8_BAR;
            PG8_LDA(At, 1, 1); PG8_STAGE(PG8_SA(1, 0), a3, voffA);
            PG8_BAR; PG8_WAIT_L(0); PG8_MMA(1, 0, At, B0); PG8_BAR; PG8_SCHED;
            PG8_STAGE(PG8_SB(1, 1), b3 + hstep, voffB);
            PG8_WAIT_V(6); PG8_BAR; PG8_MMA(1, 1, At, B1); PG8_BAR;
            }
        }
        if constexpr (ALIGN_EPI) { if (wr == 0) PG8_BAR; }
        if constexpr (!Epi::AFTER_DRAIN) { E(acc, cur, wr, wc, fr, fq); S.done(cur); }
        if (!has_next) break;
#pragma unroll
        for (int a = 0; a < 2; ++a)
#pragma unroll
            for (int b = 0; b < 2; ++b)
#pragma unroll
                for (int m = 0; m < 4; ++m)
#pragma unroll
                    for (int n = 0; n < 2; ++n) acc[a][b][m][n] = (f32x4){0.f, 0.f, 0.f, 0.f};
        cur = nxt; cA = nA; cB = nB; ++ui;
        if constexpr (ALIGN_EPI) { if (wr == 1) PG8_BAR; }
    }
    PG8_WAIT_V(0);
    if constexpr (!ALIGN_EPI) { if (wr == 0) PG8_BAR; }
    PG8_BAR;
    if constexpr (Epi::AFTER_DRAIN) { E.fused(acc, cur, wr, wc, fr, fq, lds, wid, lane); S.done(cur); }
#undef PG8_SA
#undef PG8_SB
#undef PG8_STAGE
#undef PG8_LDA
#undef PG8_LDB
#undef PG8_MMA
#undef PG8_WAIT_V
#undef PG8_WAIT_L
#undef PG8_BAR
#undef PG8_SCHED
}
}
constexpr int NWAVES = 8;
#ifndef MK_N_LAUNCHES
#define MK_N_LAUNCHES 1
#endif
#ifndef PROBE_DUP
#define PROBE_DUP -1
#endif
#ifndef PROBE_XBAR
#define PROBE_XBAR 0
#endif
constexpr int N_LAUNCHES = MK_N_LAUNCHES;
constexpr int NPH = 8;
constexpr int D = 1024, BATCH = 2, SEQ = 8192, M = BATCH * SEQ, DIN = 2560, DEPTH = 2;
constexpr int C_UPOOL = 0, C_GPOOL = 256, C_CA = 512, C_CB = 768, C_GCONV = 1024, C_Q = 1280, C_K = 1792, C_V = 1920, C_GATTN = 2048;
constexpr float EPS = 1e-6f;
constexpr size_t MiB = 1u << 20;
constexpr size_t WS_CTL = 0, CTL_ZERO_BYTES = 1 * MiB;
constexpr size_t WS_WIN = 2 * MiB;
constexpr size_t WS_WOUT = 12 * MiB;
constexpr size_t WS_WPW = 16 * MiB;
constexpr size_t WS_WPOOL = 16 * MiB + 512 * 1024;
constexpr size_t WS_SSP = 17 * MiB;
constexpr size_t WS_XB = 32 * MiB;
constexpr size_t WS_PROJ = 64 * MiB;
constexpr size_t WS_Y = 144 * MiB;
constexpr size_t WS_END = 176 * MiB;
constexpr int CW_BAR = 4096;
constexpr int RING_OFF = 0, RING_BYTES = 131072, LDSCTL_OFF = 146432, MISC_OFF = LDSCTL_OFF + 320, LDS_BYTES = 147456;
#define GAS __attribute__((address_space(1)))
#define LAS __attribute__((address_space(3)))
typedef unsigned short bf16;
typedef unsigned v4u __attribute__((ext_vector_type(4)));
typedef float f32x4 __attribute__((ext_vector_type(4)));
typedef short bf16x8 __attribute__((ext_vector_type(8)));
typedef GAS unsigned gu32;
typedef GAS unsigned long long gu64;
#define RLX_AGENT __ATOMIC_RELAXED, __HIP_MEMORY_SCOPE_AGENT
#define LDS_WAIT() asm volatile("s_waitcnt lgkmcnt(0)" ::: "memory")
#define VM_WAIT() asm volatile("s_waitcnt vmcnt(0)" ::: "memory")
__device__ __forceinline__ unsigned long long rt() { return __builtin_amdgcn_s_memrealtime(); }
__device__ __forceinline__ unsigned f2bf(float f) { unsigned u = __builtin_bit_cast(unsigned, f); return (u + 0x7fffu + ((u >> 16) & 1u)) >> 16; }
__device__ __forceinline__ unsigned pk2(float lo, float hi) { return f2bf(lo) | (f2bf(hi) << 16); }
#define XB_TMO      128
#define XB_XCNT(j)  (256  + 64 * (j))
#define XB_XSUB(j)  (1280 + 64 * (j))
#define XB_XGEN(j)  (2304 + 64 * (j))
#define XB_TOP      3328
#define XB_TOPGEN   3392
#define XCD_BAR_WORDS 3456
#define XB_SPIN_CAP (1u << 18)

__device__ __forceinline__ unsigned xb_ld(unsigned* p)              { return __hip_atomic_load(p, __ATOMIC_RELAXED, __HIP_MEMORY_SCOPE_AGENT); }
__device__ __forceinline__ unsigned xb_add(unsigned* p, unsigned v) { return __hip_atomic_fetch_add(p, v, __ATOMIC_RELAXED, __HIP_MEMORY_SCOPE_AGENT); }
__device__ __forceinline__ unsigned xb_xcc_id() { return (unsigned)__builtin_amdgcn_s_getreg((3 << 11) | 20) & 0xFu; }
#define XB_SPIN(cond, bar) do { unsigned _sp = 0; while (cond) { __builtin_amdgcn_s_sleep(1); \
    if ((++_sp & 255u) == 0u) { if (xb_ld(&(bar)[XB_TMO])) break; if (_sp > XB_SPIN_CAP) { atomicAdd(&(bar)[XB_TMO], 1u); break; } } } } while (0)

struct XcdBarrier {
    unsigned* bar; unsigned x;
    volatile LAS unsigned* st;
};

__device__ __forceinline__ XcdBarrier xcd_barrier_post(unsigned* bar, volatile LAS unsigned* st) {
    XcdBarrier b; b.bar = bar; b.x = xb_xcc_id(); b.st = st;
    if (threadIdx.x == 0) (void)xb_add(&bar[XB_XCNT(b.x)], 1u);
    return b;
}
__device__ __forceinline__ void xcd_barrier_complete(unsigned* bar, unsigned x, unsigned& nloc, unsigned& nx) {
    const unsigned G = gridDim.x * gridDim.y * gridDim.z;
    unsigned sum, cnt, mine, sp = 0u;
    for (;;) {
        sum = 0u; cnt = 0u; mine = 0u;
#pragma unroll
        for (unsigned j = 0; j < 16; ++j) { const unsigned c = xb_ld(&bar[XB_XCNT(j)]); sum += c; cnt += (c > 0u) ? 1u : 0u; mine = (j == x) ? c : mine; }
        if (sum == G) break;
        __builtin_amdgcn_s_sleep(1);
        if ((++sp & 255u) == 0u) { if (xb_ld(&bar[XB_TMO])) break; if (sp > XB_SPIN_CAP) { atomicAdd(&bar[XB_TMO], 1u); break; } }
    }
    nloc = mine > 0u ? mine : 1u; nx = cnt > 0u ? cnt : 1u;
}

__device__ __forceinline__ void xcd_barrier(const XcdBarrier& b) {
    asm volatile("s_waitcnt vmcnt(0)" ::: "memory");
    __syncthreads();
    if (threadIdx.x == 0) {
        unsigned* bar = b.bar;
        __builtin_amdgcn_s_waitcnt(0);
        unsigned nloc = b.st[0], nx = b.st[1];
        if (nloc == 0u) { xcd_barrier_complete(bar, b.x, nloc, nx); b.st[0] = nloc; b.st[1] = nx; }
        const unsigned old = xb_add(&bar[XB_XSUB(b.x)], 1u);
        const unsigned gen = old / nloc;
        if (old + 1u == (gen + 1u) * nloc) {
            __builtin_amdgcn_fence(__ATOMIC_RELEASE, "agent");
            asm volatile("s_waitcnt vmcnt(0)" ::: "memory");
            const unsigned og = xb_add(&bar[XB_TOP], 1u);
            const unsigned tg = og / nx;
            if (og + 1u == (tg + 1u) * nx) xb_add(&bar[XB_TOPGEN], 1u);
            else XB_SPIN(xb_ld(&bar[XB_TOPGEN]) == tg, bar);
            __builtin_amdgcn_fence(__ATOMIC_ACQUIRE, "agent");
            xb_add(&bar[XB_XGEN(b.x)], 1u);
            asm volatile("s_waitcnt vmcnt(0)" ::: "memory");
        } else {
            XB_SPIN(xb_ld(&bar[XB_XGEN(b.x)]) == gen, bar);
            __builtin_amdgcn_fence(__ATOMIC_ACQUIRE, "agent");
            asm volatile("s_waitcnt vmcnt(0)" ::: "memory");
        }
    }
    __syncthreads();
}
typedef float f32x16 __attribute__((ext_vector_type(16)));
typedef short s16x4 __attribute__((ext_vector_type(4)));
typedef float f32x2_t __attribute__((ext_vector_type(2)));
typedef __bf16 bf16x2_t __attribute__((ext_vector_type(2)));
#define MFMA32(a, b, c) __builtin_amdgcn_mfma_f32_32x32x16_bf16((a), (b), (c), 0, 0, 0)
__device__ __forceinline__ int crow(int r, int hi) { return (r & 3) + 8 * (r >> 2) + 4 * hi; }
__device__ __forceinline__ unsigned cvtpk(float lo, float hi) { f32x2_t v = {lo, hi}; bf16x2_t b = __builtin_convertvector(v, bf16x2_t); return __builtin_bit_cast(unsigned, b); }
__device__ __forceinline__ float bflo(unsigned w) { return __uint_as_float(w << 16); }
__device__ __forceinline__ float bfhi(unsigned w) { return __uint_as_float(w & 0xffff0000u); }
__device__ __forceinline__ float fsilu(float x) { return x * __builtin_amdgcn_rcpf(1.f + __builtin_amdgcn_exp2f(-1.4426950408889634f * x)); }
__device__ __forceinline__ float fsigm(float x) { return __builtin_amdgcn_rcpf(1.f + __builtin_amdgcn_exp2f(-1.4426950408889634f * x)); }
__device__ __forceinline__ bf16x8 packP(const f32x16& p, int s) {
    v4u w; w.x = cvtpk(p[8 * s], p[8 * s + 1]); w.y = cvtpk(p[8 * s + 2], p[8 * s + 3]); w.z = cvtpk(p[8 * s + 4], p[8 * s + 5]); w.w = cvtpk(p[8 * s + 6], p[8 * s + 7]);
    return __builtin_bit_cast(bf16x8, w);
}
constexpr int STG_LD = 36;
constexpr int BL_STG = 0, BL_INVL = 8 * 32 * STG_LD * 4, BL_R1 = BL_INVL + 1024;
constexpr int AST = 528;
constexpr int CV_GLU = BL_R1, CV_HN = BL_R1, CV_OUT = BL_R1 + 62 * 1024;
constexpr int PL_U = BL_R1, PL_DIFF = BL_R1 + 47 * 1024;
constexpr int AT_K = BL_R1, AT_V = BL_R1 + 32768;
static_assert(CV_OUT + 32768 <= 146432 && PL_DIFF + 32 * AST <= 146432 && AT_V + 32768 <= 146432, "mixer LDS map");

__device__ __forceinline__ void gate_load(v4u (&gq)[2], const bf16* gate, int lane) {
#pragma unroll
    for (int it = 0; it < 2; ++it) { const int idx = it * 64 + lane, row = idx >> 2, c8 = (idx & 3) * 8; gq[it] = *(const GAS v4u*)(gate + (size_t)row * DIN + c8); }
}
__device__ __forceinline__ void tile_out(const f32x16& acc, float colscale, LAS float* stg, const LAS float* rowscale, const v4u (&gq)[2], bf16* yp, int lane) {
    const int r32 = lane & 31, hi = lane >> 5;
#pragma unroll
    for (int reg = 0; reg < 16; ++reg) stg[crow(reg, hi) * STG_LD + r32] = acc[reg] * colscale;
#pragma unroll
    for (int it = 0; it < 2; ++it) {
        const int idx = it * 64 + lane, row = idx >> 2, c8 = (idx & 3) * 8;
        f32x4 v0 = *(const LAS f32x4*)(stg + row * STG_LD + c8), v1 = *(const LAS f32x4*)(stg + row * STG_LD + c8 + 4);
        if (rowscale) { const float rs = rowscale[row]; v0 = v0 * rs; v1 = v1 * rs; }
        v4u o;
        o.x = cvtpk(v0[0] * fsilu(bflo(gq[it].x)), v0[1] * fsilu(bfhi(gq[it].x)));
        o.y = cvtpk(v0[2] * fsilu(bflo(gq[it].y)), v0[3] * fsilu(bfhi(gq[it].y)));
        o.z = cvtpk(v1[0] * fsilu(bflo(gq[it].z)), v1[1] * fsilu(bfhi(gq[it].z)));
        o.w = cvtpk(v1[2] * fsilu(bflo(gq[it].w)), v1[3] * fsilu(bfhi(gq[it].w)));
        *(GAS v4u*)(yp + (size_t)row * D + c8) = o;
    }
}

struct MixW { const float *pool_scale, *dw, *cb, *lg, *lb, *sinks; const bf16 *wpw, *wpool; };

__device__ __forceinline__ void conv_unit(LAS unsigned char* L, const bf16* PROJ, bf16* Y, const MixW& W, int tok0, int tid, int lane, int wave) {
    LAS float* GLU = (LAS float*)(L + CV_GLU); LAS float* CO = (LAS float*)(L + CV_OUT); LAS unsigned char* HN = L + CV_HN;
    const int t0 = tok0 & (SEQ - 1);
    v4u gq[2]; gate_load(gq, PROJ + (size_t)tok0 * DIN + C_GCONV + 32 * wave, lane);
    {
        v4u av[4], bv[4];
#pragma unroll
        for (int i = 0; i < 4; ++i) { const int e = tid + 512 * i, r = e >> 5, c8 = (e & 31) * 8;
            av[i] = (v4u){0u, 0u, 0u, 0u}; bv[i] = av[i];
            if (e < 62 * 32 && t0 - 30 + r >= 0) { const bf16* pr = PROJ + (size_t)(tok0 - 30 + r) * DIN; av[i] = *(const GAS v4u*)(pr + C_CA + c8); bv[i] = *(const GAS v4u*)(pr + C_CB + c8); } }
#pragma unroll
        for (int i = 0; i < 4; ++i) { const int e = tid + 512 * i, r = e >> 5, c8 = (e & 31) * 8;
            if (e < 62 * 32) { const v4u a = av[i], b = bv[i]; f32x4 g0, g1;
                g0[0] = bflo(a.x) * fsigm(bflo(b.x)); g0[1] = bfhi(a.x) * fsigm(bfhi(b.x)); g0[2] = bflo(a.y) * fsigm(bflo(b.y)); g0[3] = bfhi(a.y) * fsigm(bfhi(b.y));
                g1[0] = bflo(a.z) * fsigm(bflo(b.z)); g1[1] = bfhi(a.z) * fsigm(bfhi(b.z)); g1[2] = bflo(a.w) * fsigm(bflo(b.w)); g1[3] = bfhi(a.w) * fsigm(bfhi(b.w));
                *(LAS f32x4*)(GLU + r * 256 + c8) = g0; *(LAS f32x4*)(GLU + r * 256 + c8 + 4) = g1; } }
    }
    __syncthreads();
    {
        const int c = tid & 255, th = tid >> 8;
        float w[31];
#pragma unroll
        for (int j = 0; j < 31; ++j) w[j] = W.dw[j * 256 + c];
        const float bias = W.cb[c];
#pragma unroll
        for (int grp = 0; grp < 2; ++grp) {
            const int o0 = 16 * th + 8 * grp;
            float in[38];
#pragma unroll
            for (int k = 0; k < 38; ++k) in[k] = GLU[(o0 + k) * 256 + c];
#pragma unroll
            for (int o = 0; o < 8; ++o) { float a = bias;
#pragma unroll
                for (int j = 0; j < 31; ++j) a += w[j] * in[o + j];
                CO[(o0 + o) * 256 + c] = a; }
        }
    }
    __syncthreads();
    {
        const int tk = tid >> 4, part = tid & 15;
        f32x4 v[4]; float s = 0.f;
#pragma unroll
        for (int i = 0; i < 4; ++i) { v[i] = *(const LAS f32x4*)(CO + tk * 256 + 64 * i + 4 * part); s += (v[i][0] + v[i][1]) + (v[i][2] + v[i][3]); }
        s += __shfl_xor(s, 1); s += __shfl_xor(s, 2); s += __shfl_xor(s, 4); s += __shfl_xor(s, 8);
        const float mu = s * (1.f / 256.f); float q = 0.f;
#pragma unroll
        for (int i = 0; i < 4; ++i) { v[i] = v[i] - mu; q += (v[i][0] * v[i][0] + v[i][1] * v[i][1]) + (v[i][2] * v[i][2] + v[i][3] * v[i][3]); }
        q += __shfl_xor(q, 1); q += __shfl_xor(q, 2); q += __shfl_xor(q, 4); q += __shfl_xor(q, 8);
        const float rstd = rsqrtf(q * (1.f / 256.f) + EPS);
#pragma unroll
        for (int i = 0; i < 4; ++i) { const int c = 64 * i + 4 * part; const f32x4 gg = *(const GAS f32x4*)(W.lg + c), bb = *(const GAS f32x4*)(W.lb + c);
            const f32x4 y = v[i] * rstd * gg + bb;
            pg8::u32x2 o; o.x = cvtpk(fsilu(y[0]), fsilu(y[1])); o.y = cvtpk(fsilu(y[2]), fsilu(y[3]));
            *(LAS pg8::u32x2*)(HN + tk * AST + c * 2) = o; }
    }
    __syncthreads();
    {
        const int r32 = lane & 31, hi = lane >> 5;
        const bf16* wrow = W.wpw + (size_t)(32 * wave + r32) * 256 + 8 * hi;
        f32x16 acc = {};
#pragma unroll
        for (int s = 0; s < 16; ++s) { const bf16x8 bfr = *(const GAS bf16x8*)(wrow + 16 * s); const bf16x8 a = *(const LAS bf16x8*)(HN + r32 * AST + (16 * s + 8 * hi) * 2); acc = MFMA32(a, bfr, acc); }
        tile_out(acc, 1.f, (LAS float*)(L + BL_STG) + wave * 32 * STG_LD, nullptr, gq, Y + (size_t)tok0 * D + 256 + 32 * wave, lane);
    }
    __syncthreads();
}

__device__ __forceinline__ void pool_unit(LAS unsigned char* L, const bf16* PROJ, bf16* Y, const MixW& W, int tok0, int tid, int lane, int wave) {
    LAS float* U = (LAS float*)(L + PL_U); LAS unsigned char* DF = L + PL_DIFF;
    const int t0 = tok0 & (SEQ - 1);
    v4u gq[2]; gate_load(gq, PROJ + (size_t)tok0 * DIN + C_GPOOL + 32 * wave, lane);
    {
        v4u av[3];
#pragma unroll
        for (int i = 0; i < 3; ++i) { const int e = tid + 512 * i, r = e >> 5, c8 = (e & 31) * 8;
            av[i] = (v4u){0u, 0u, 0u, 0u};
            if (e < 47 * 32 && t0 - 15 + r >= 0) av[i] = *(const GAS v4u*)(PROJ + (size_t)(tok0 - 15 + r) * DIN + C_UPOOL + c8); }
#pragma unroll
        for (int i = 0; i < 3; ++i) { const int e = tid + 512 * i, r = e >> 5, c8 = (e & 31) * 8;
            if (e < 47 * 32) { const v4u a = av[i]; f32x4 g0, g1;
                g0[0] = bflo(a.x); g0[1] = bfhi(a.x); g0[2] = bflo(a.y); g0[3] = bfhi(a.y); g1[0] = bflo(a.z); g1[1] = bfhi(a.z); g1[2] = bflo(a.w); g1[3] = bfhi(a.w);
                *(LAS f32x4*)(U + r * 256 + c8) = g0; *(LAS f32x4*)(U + r * 256 + c8 + 4) = g1; } }
    }
    __syncthreads();
    {
        const int c = tid & 255, th = tid >> 8, g = wave & 3, wnd = 2 << g;
        const int R0 = 16 * th + 15;
        float s = 0.f;
        for (int k = 0; k < wnd; ++k) s += U[(R0 - k) * 256 + c];
#pragma unroll 4
        for (int o = 0; o < 16; ++o) {
            const int tp = t0 + 16 * th + o; const int cnt = (tp + 1 < wnd) ? tp + 1 : wnd;
            const float uv = U[(R0 + o) * 256 + c];
            const float df = s * __builtin_amdgcn_rcpf((float)cnt) - uv;
            *(LAS bf16*)(DF + (16 * th + o) * AST + c * 2) = (bf16)(cvtpk(df, 0.f) & 0xffffu);
            if (o < 15) s += U[(R0 + o + 1) * 256 + c] - U[(R0 + o + 1 - wnd) * 256 + c];
        }
    }
    __syncthreads();
    {
        const int r32 = lane & 31, hi = lane >> 5, g = wave >> 1, db = wave & 1;
        const bf16* wrow = W.wpool + (size_t)g * 4096 + (size_t)(32 * db + r32) * 64 + 8 * hi;
        f32x16 acc = {};
#pragma unroll
        for (int s = 0; s < 4; ++s) { const bf16x8 bfr = *(const GAS bf16x8*)(wrow + 16 * s); const bf16x8 a = *(const LAS bf16x8*)(DF + r32 * AST + (64 * g + 16 * s + 8 * hi) * 2); acc = MFMA32(a, bfr, acc); }
        tile_out(acc, W.pool_scale[32 * wave + r32], (LAS float*)(L + BL_STG) + wave * 32 * STG_LD, nullptr, gq, Y + (size_t)tok0 * D + 32 * wave, lane);
    }
    __syncthreads();
}

__device__ __forceinline__ void attn_unit(LAS unsigned char* L, const bf16* PROJ, bf16* Y, const MixW& W, int unit, int tid, int lane, int wave) {
    const int n = unit & 63, kvh = (unit >> 6) & 1, b = unit >> 7;
    const int tokq0 = b * SEQ + n * 128;
    LAS unsigned char* KL = L + AT_K; LAS unsigned char* VL = L + AT_V;
    const int r32 = lane & 31, hi = lane >> 5;
    const int hq = kvh * 4 + (wave >> 1);
    {
        v4u kq[4], vq[4];
#pragma unroll
        for (int i = 0; i < 4; ++i) { const int e = tid + 512 * i, j = e >> 3, ch = e & 7;
            kq[i] = (v4u){0u, 0u, 0u, 0u}; vq[i] = kq[i];
            if (n > 0 || j >= 128) { const bf16* pr = PROJ + (size_t)(tokq0 - 128 + j) * DIN + kvh * 64 + ch * 8; kq[i] = *(const GAS v4u*)(pr + C_K); vq[i] = *(const GAS v4u*)(pr + C_V); } }
#pragma unroll
        for (int i = 0; i < 4; ++i) { const int e = tid + 512 * i, j = e >> 3, ch = e & 7;
            *(LAS v4u*)(KL + j * 128 + ((ch ^ (j & 7)) << 4)) = kq[i];
            *(LAS v4u*)(VL + j * 128 + ((ch ^ (((j >> 1) & 1) << 2)) << 4)) = vq[i]; }
    }
    __syncthreads();
    const float slope2 = exp2f(-(float)(hq + 1)) * 1.4426950408889634f, sink2 = W.sinks[hq] * 1.4426950408889634f;
    const float c1 = 0.125f * 1.4426950408889634f;
    LAS float* stg = (LAS float*)(L + BL_STG) + wave * 32 * STG_LD;
    LAS float* invl = (LAS float*)(L + BL_INVL) + wave * 32;
#pragma unroll 1
    for (int blk = 0; blk < 2; ++blk) {
        const int i0 = (wave & 1) * 64 + blk * 32, jt0 = i0 >> 5;
        bf16x8 qf[4]; v4u gq[2][2];
        {
            const bf16* qrow = PROJ + (size_t)(tokq0 + i0 + r32) * DIN + C_Q + hq * 64 + 8 * hi;
#pragma unroll
            for (int s = 0; s < 4; ++s) qf[s] = *(const GAS bf16x8*)(qrow + 16 * s);
            const bf16* gate = PROJ + (size_t)(tokq0 + i0) * DIN + C_GATTN + hq * 64;
            gate_load(gq[0], gate, lane); gate_load(gq[1], gate + 32, lane);
        }
        f32x16 p[5];
        float mx = sink2;
#pragma unroll
        for (int d = 0; d < 5; ++d) {
            const int jt = jt0 + d;
            f32x16 a = {};
#pragma unroll
            for (int s = 0; s < 4; ++s) { const int key = 32 * jt + r32; const bf16x8 kf = *(const LAS bf16x8*)(KL + key * 128 + (((2 * s + hi) ^ (key & 7)) << 4)); a = MFMA32(kf, qf[s], a); }
            const bool tile_ok = (n > 0) || (jt >= 4);
            const float distb = (float)(128 + i0 + r32 - 32 * jt - 4 * hi);
#pragma unroll
            for (int reg = 0; reg < 16; ++reg) {
                const float dist = distb - (float)((reg & 3) + 8 * (reg >> 2));
                const float v = a[reg] * c1 - slope2 * dist;
                const bool ok = tile_ok && dist >= 0.f && dist < 128.f;
                a[reg] = ok ? v : -1e30f;
                mx = fmaxf(mx, a[reg]);
            }
            p[d] = a;
        }
        mx = fmaxf(mx, __shfl_xor(mx, 32));
        float lsum = 0.f;
#pragma unroll
        for (int d = 0; d < 5; ++d)
#pragma unroll
            for (int reg = 0; reg < 16; ++reg) { const float e = __builtin_amdgcn_exp2f(p[d][reg] - mx); p[d][reg] = e; lsum += e; }
        lsum += __shfl_xor(lsum, 32);
        lsum += __builtin_amdgcn_exp2f(sink2 - mx);
        if (hi == 0) invl[r32] = __builtin_amdgcn_rcpf(lsum);
        f32x16 o0 = {}, o1 = {};
        const int q4 = (lane & 15) >> 2, p4 = lane & 3, g2 = (lane >> 4) & 1;
#pragma unroll
        for (int d = 0; d < 5; ++d) {
            const int jt = jt0 + d;
#pragma unroll
            for (int s = 0; s < 2; ++s) {
                const bf16x8 pa = packP(p[d], s);
                const int keyA = 32 * jt + 16 * s + 4 * hi + q4, keyB = keyA + 8;
                const int offA = keyA * 128 + 32 * g2 + 8 * p4, offB = keyB * 128 + 32 * g2 + 8 * p4;
                const int swA = ((keyA >> 1) & 1) << 6, swB = ((keyB >> 1) & 1) << 6;
                const s16x4 a0 = __builtin_bit_cast(s16x4, __builtin_amdgcn_ds_read_tr16_b64_v4i16((LAS s16x4*)(VL + (offA ^ swA))));
                const s16x4 b0 = __builtin_bit_cast(s16x4, __builtin_amdgcn_ds_read_tr16_b64_v4i16((LAS s16x4*)(VL + (offB ^ swB))));
                const s16x4 a1 = __builtin_bit_cast(s16x4, __builtin_amdgcn_ds_read_tr16_b64_v4i16((LAS s16x4*)(VL + ((offA + 64) ^ swA))));
                const s16x4 b1 = __builtin_bit_cast(s16x4, __builtin_amdgcn_ds_read_tr16_b64_v4i16((LAS s16x4*)(VL + ((offB + 64) ^ swB))));
                const bf16x8 v0 = {a0[0], a0[1], a0[2], a0[3], b0[0], b0[1], b0[2], b0[3]}, v1 = {a1[0], a1[1], a1[2], a1[3], b1[0], b1[1], b1[2], b1[3]};
                o0 = MFMA32(pa, v0, o0); o1 = MFMA32(pa, v1, o1);
            }
        }
        bf16* yp = Y + (size_t)(tokq0 + i0) * D + 512 + hq * 64;
        tile_out(o0, 1.f, stg, invl, gq[0], yp, lane);
        tile_out(o1, 1.f, stg, invl, gq[1], yp + 32, lane);
    }
    __syncthreads();
}
__device__ __forceinline__ float bf2f(bf16 v) { return __uint_as_float((unsigned)v << 16); }
__device__ __forceinline__ float wave_sum(float v) {
#pragma unroll
    for (int o = 1; o < 64; o <<= 1) v += __shfl_xor(v, o);
    return v;
}
__device__ __forceinline__ float silu_f(float x) { return x / (1.f + __expf(-x)); }
__device__ __forceinline__ float sigmoid_f(float x) { return 1.f / (1.f + __expf(-x)); }

__device__ __forceinline__ void p0_transpose_item(const float* W, int K, int N, bf16* WT, LAS float* scr, int item, int lane, const float* kscale) {
    const int nblk = N / 32, kb = item / nblk, nb = item % nblk, k0 = 64 * kb, n0 = 32 * nb;
#pragma unroll
    for (int i = 0; i < 32; ++i) { const int kk = 2 * i + (lane >> 5); float v = W[(size_t)(k0 + kk) * N + n0 + (lane & 31)]; if (kscale) v *= kscale[k0 + kk]; scr[kk * 33 + (lane & 31)] = v; }
    LDS_WAIT(); asm volatile("" ::: "memory");
    const int c = lane & 7;
#pragma unroll
    for (int j = 0; j < 4; ++j) { const int n = (lane >> 3) + 8 * j; const LAS float* s = scr + (8 * c) * 33 + n;
        v4u o; o.x = pk2(s[0 * 33], s[1 * 33]); o.y = pk2(s[2 * 33], s[3 * 33]); o.z = pk2(s[4 * 33], s[5 * 33]); o.w = pk2(s[6 * 33], s[7 * 33]);
        *(GAS v4u*)(WT + (size_t)(n0 + n) * K + k0 + 8 * c) = o; }
    LDS_WAIT(); asm volatile("" ::: "memory");
}

struct Args { const float* in[13]; float* out; unsigned char* ws; int ph_lo, ph_hi; };

__global__ void __launch_bounds__(NWAVES * 64, 2) fwd(Args args) {
    extern __shared__ __attribute__((aligned(16))) unsigned char lds[];
    LAS unsigned char* L = (LAS unsigned char*)lds;
    volatile LAS unsigned* MISC = (volatile LAS unsigned*)(L + MISC_OFF);
    const int tid = threadIdx.x, lane = tid & 63, wave = __builtin_amdgcn_readfirstlane(tid >> 6);
    const int G = gridDim.x;
    unsigned char* ws = args.ws;
    gu32* ctl = (gu32*)(ws + WS_CTL);
    const float* x = args.in[0]; const float* ln_g = args.in[1]; const float* w_in = args.in[2]; const float* pool_w = args.in[3]; const float* pool_scale = args.in[4];
    const float* conv_dw = args.in[5]; const float* conv_b = args.in[6]; const float* conv_ln_g = args.in[7]; const float* conv_ln_b = args.in[8]; const float* conv_pw = args.in[9];
    const float* attn_sinks = args.in[10]; const float* w_out = args.in[11]; const float* final_g = args.in[12];
    float* out = args.out;
    bf16* WIN = (bf16*)(ws + WS_WIN); bf16* WOUT = (bf16*)(ws + WS_WOUT); bf16* WPW = (bf16*)(ws + WS_WPW); bf16* WPOOL = (bf16*)(ws + WS_WPOOL);
    float* SSP = (float*)(ws + WS_SSP); bf16* XB = (bf16*)(ws + WS_XB); bf16* PROJ = (bf16*)(ws + WS_PROJ); bf16* Y = (bf16*)(ws + WS_Y);
    for (int u = tid; u < (LDS_BYTES - LDSCTL_OFF) / 4; u += NWAVES * 64) ((LAS unsigned*)(L + LDSCTL_OFF))[u] = 0u;
    __syncthreads();
    XcdBarrier bar; bar.bar = (unsigned*)(ctl + CW_BAR); bar.x = 0; bar.st = nullptr;
    if (N_LAUNCHES == 1) bar = xcd_barrier_post((unsigned*)(ctl + CW_BAR), MISC + 8);
    const int lo = args.ph_lo, hi = args.ph_hi;
#define IN(k) (lo <= (k) && (k) < hi)
#define SEAM(k) do { if (IN(k) && IN((k) + 1)) xcd_barrier(bar); } while (0)
#define REPS(k) ((PROBE_DUP == (k)) ? 2 : 1)

    for (int rep = 0; rep < REPS(0); ++rep) { if (rep) xcd_barrier(bar);
    if (IN(0)) {
        LAS float* scr = (LAS float*)(L + RING_OFF + wave * 16384);
        const int gw = blockIdx.x * NWAVES + wave, NGW = G * NWAVES;
        constexpr int I_IN = (D / 64) * (DIN / 32), I_OUT = (D / 64) * (D / 32), I_PW = (256 / 64) * (256 / 32), I_PL = 2;
        constexpr int NITEMS = DEPTH * (I_IN + I_OUT + I_PW + 4 * I_PL);
        for (int it = gw; it < NITEMS; it += NGW) {
            int r = it;
            if (r < DEPTH * I_IN) { const int l = r / I_IN; p0_transpose_item(w_in + (size_t)l * D * DIN, D, DIN, WIN + (size_t)l * DIN * D, scr, r % I_IN, lane, ln_g + l * D); continue; } r -= DEPTH * I_IN;
            if (r < DEPTH * I_OUT) { const int l = r / I_OUT; p0_transpose_item(w_out + (size_t)l * D * D, D, D, WOUT + (size_t)l * D * D, scr, r % I_OUT, lane, nullptr); continue; } r -= DEPTH * I_OUT;
            if (r < DEPTH * I_PW) { const int l = r / I_PW; p0_transpose_item(conv_pw + (size_t)l * 65536, 256, 256, WPW + (size_t)l * 65536, scr, r % I_PW, lane, nullptr); continue; } r -= DEPTH * I_PW;
            { const int lg = r / I_PL; p0_transpose_item(pool_w + (size_t)lg * 4096, 64, 64, WPOOL + (size_t)lg * 4096, scr, r % I_PL, lane, nullptr); }
        }
        for (int m0 = gw; m0 < M; m0 += 4 * NGW) {
            f32x4 v[4][4];
#pragma unroll
            for (int r = 0; r < 4; ++r) { const int m = m0 + r * NGW; if (m < M) { const GAS f32x4* xr = (const GAS f32x4*)(x + (size_t)m * D) + lane;
#pragma unroll
                for (int j = 0; j < 4; ++j) v[r][j] = xr[64 * j]; } }
#pragma unroll
            for (int r = 0; r < 4; ++r) { const int m = m0 + r * NGW; if (m < M) { float s = 0.f;
#pragma unroll
                for (int j = 0; j < 4; ++j) s += (v[r][j].x * v[r][j].x + v[r][j].y * v[r][j].y) + (v[r][j].z * v[r][j].z + v[r][j].w * v[r][j].w);
                s = wave_sum(s);
                GAS unsigned long long* o8 = (GAS unsigned long long*)(XB + (size_t)m * D) + lane;
#pragma unroll
                for (int j = 0; j < 4; ++j) o8[64 * j] = (unsigned long long)pk2(v[r][j].x, v[r][j].y) | ((unsigned long long)pk2(v[r][j].z, v[r][j].w) << 32);
                if (lane == 0) *(f32x4*)(SSP + (size_t)m * 4) = (f32x4){s, 0.f, 0.f, 0.f}; } }
        }
    }
    }
    SEAM(0);
    for (int i = 0; i < PROBE_XBAR; ++i) xcd_barrier(bar);
    for (int l = 0; l < DEPTH; ++l) {
        const int pb = 1 + 3 * l;
        for (int rep = 0; rep < REPS(pb); ++rep) { if (rep) xcd_barrier(bar);
        if (IN(pb)) {
            pg8::Gemm g{XB, WIN + (size_t)l * DIN * D, M, DIN, D}; pg8::StaticOrder S; S.init(M, DIN, G, (int)blockIdx.x);
            pg8::EpiProj E{PROJ, DIN, SSP + (size_t)l * M * 4};
            pg8::gemm_phase<pg8::EpiProj, pg8::StaticOrder, true, true>(L + RING_OFF, g, S, E);
        }
        }
        SEAM(pb);
        for (int rep = 0; rep < REPS(pb + 1); ++rep) { if (rep) xcd_barrier(bar);
        if (IN(pb + 1)) {
            int tid = threadIdx.x; asm volatile("" : "+v"(tid));
            const int lane = tid & 63;
            MixW W{pool_scale + l * 256, conv_dw + l * 31 * 256, conv_b + l * 256, conv_ln_g + l * 256, conv_ln_b + l * 256, attn_sinks + l * 8, WPW + (size_t)l * 65536, WPOOL + (size_t)l * 16384};
            for (int u = blockIdx.x; u < 256; u += G) attn_unit(L, PROJ, Y, W, u, tid, lane, wave);
            for (int u = blockIdx.x; u < 512; u += G) conv_unit(L, PROJ, Y, W, 32 * u, tid, lane, wave);
            for (int u = blockIdx.x; u < 512; u += G) pool_unit(L, PROJ, Y, W, 32 * u, tid, lane, wave);
        }
        }
        SEAM(pb + 1);
        if (IN(pb + 2)) {
            pg8::Gemm g{Y, WOUT + (size_t)l * D * D, M, D, D}; pg8::StaticOrder S; S.init(M, D, G, (int)blockIdx.x);
            pg8::EpiRes E{x, XB, SSP + (size_t)(l + 1) * M * 4, D, l};
            pg8::gemm_phase<pg8::EpiRes, pg8::StaticOrder, false, true>(L + RING_OFF, g, S, E);
        }
        SEAM(pb + 2);
    }
    if (IN(7)) {
        int tid = threadIdx.x; asm volatile("" : "+v"(tid));
        const int lane = tid & 63;
        const int gw = blockIdx.x * NWAVES + wave, NGW = G * NWAVES;
        const float* ssp2 = SSP + (size_t)2 * M * 4;
        f32x4 gg[4];
#pragma unroll
        for (int h = 0; h < 2; ++h) { gg[2 * h] = *(const GAS f32x4*)(final_g + 512 * h + 8 * lane); gg[2 * h + 1] = *(const GAS f32x4*)(final_g + 512 * h + 8 * lane + 4); }
        for (int m0 = gw; m0 < M; m0 += 4 * NGW) {
            v4u xv[4][2]; f32x4 sp[4];
#pragma unroll
            for (int r = 0; r < 4; ++r) { const int m = m0 + r * NGW; if (m < M) { xv[r][0] = *(const GAS v4u*)(XB + (size_t)m * D + 8 * lane); xv[r][1] = *(const GAS v4u*)(XB + (size_t)m * D + 512 + 8 * lane); sp[r] = *(const GAS f32x4*)(ssp2 + (size_t)m * 4); } }
#pragma unroll
            for (int r = 0; r < 4; ++r) { const int m = m0 + r * NGW; if (m < M) {
                const float rs = rsqrtf(((sp[r][0] + sp[r][1]) + (sp[r][2] + sp[r][3])) * (1.f / D) + EPS);
#pragma unroll
                for (int h = 0; h < 2; ++h) { const v4u w = xv[r][h];
                    const f32x4 a = (f32x4){bflo(w.x), bfhi(w.x), bflo(w.y), bfhi(w.y)} * rs * gg[2 * h], b = (f32x4){bflo(w.z), bfhi(w.z), bflo(w.w), bfhi(w.w)} * rs * gg[2 * h + 1];
                    GAS f32x4* o = (GAS f32x4*)(out + (size_t)m * D + 512 * h + 8 * lane); o[0] = a; o[1] = b; } } }
        }
    }
#undef IN
#undef SEAM
}

extern "C" void kernel_launch(void* const* d_in, const int* in_sizes, int n_in, void* d_out, int out_size, void* d_ws, size_t ws_size, hipStream_t stream) {
    static int grid = 0;
    if (grid == 0) {
        if (n_in != 13 || in_sizes[0] != M * D || out_size != M * D || ws_size < WS_END) { fprintf(stderr, "kernel_launch: unexpected shapes (n_in %d in0 %d out %d ws %zu)\n", n_in, n_in > 0 ? in_sizes[0] : -1, out_size, ws_size); grid = -1; return; }
        int dev = 0, cus = 0, per_cu = 0;
        if (hipGetDevice(&dev) != hipSuccess || hipDeviceGetAttribute(&cus, hipDeviceAttributeMultiprocessorCount, dev) != hipSuccess) { grid = -1; return; }
        if (hipFuncSetAttribute((const void*)fwd, hipFuncAttributeMaxDynamicSharedMemorySize, LDS_BYTES) != hipSuccess) { fprintf(stderr, "kernel_launch: hipFuncSetAttribute failed\n"); grid = -1; return; }
        if (hipOccupancyMaxActiveBlocksPerMultiprocessor(&per_cu, (const void*)fwd, NWAVES * 64, LDS_BYTES) != hipSuccess || per_cu < 1) { fprintf(stderr, "kernel_launch: occupancy query says %d blocks/CU\n", per_cu); }
        (void)hipGetLastError();
        if (cus != 256) { fprintf(stderr, "kernel_launch: built for a 256-CU device, found %d\n", cus); grid = -1; return; }
        grid = cus;
    }
    if (grid < 0) return;
    if (hipMemsetAsync((char*)d_ws + WS_CTL, 0, CTL_ZERO_BYTES, stream) != hipSuccess) return;
    Args a{};
    for (int i = 0; i < 13; ++i) a.in[i] = (const float*)d_in[i];
    a.out = (float*)d_out; a.ws = (unsigned char*)d_ws;
    for (int li = 0; li < N_LAUNCHES; ++li) {
        a.ph_lo = (N_LAUNCHES == 1) ? 0 : li; a.ph_hi = (N_LAUNCHES == 1) ? NPH : li + 1;
        hipLaunchKernelGGL(fwd, dim3(grid), dim3(NWAVES * 64), LDS_BYTES, stream, a);
    }
}
```

```cpp
#include <hip/hip_runtime.h>
#include <cstdio>
#include <cstdint>
namespace pg8 {
#define PG8_LAS __attribute__((address_space(3)))
typedef unsigned short bf16_t;
typedef short bf16x8 __attribute__((ext_vector_type(8)));
typedef float f32x4 __attribute__((ext_vector_type(4)));
typedef unsigned u32x4 __attribute__((ext_vector_type(4)));
constexpr int BM = 256, BK = 64, HALF = 128, HTB = HALF * BK * 2  , STAGE_BYTES = 8 * HTB, NXCD = 8, WGM = 8;

__host__ __device__ __forceinline__ int lds_byte(int r, int c) { const int st = (r >> 4) * 2 + (c >> 5), rr = r & 15, cc = c & 31, ob = rr * 64 + cc * 2; return st * 1024 + (ob ^ (((ob >> 9) & 1) << 5)); }
__host__ __device__ __forceinline__ void stage_rc(int b, int& R, int& C) { const int st = b / 1024, sb = b % 1024, swz = sb ^ (((sb >> 9) & 1) << 5); R = (st >> 1) * 16 + swz / 64; C = (st & 1) * 32 + (swz % 64) / 2; }
__host__ __device__ __forceinline__ int perm32(int rho) { const int n = rho >> 4, i = rho & 15; return 8 * (i >> 2) + 4 * n + (i & 3); }

struct Unit { int pm, pn; };
struct Gemm { const bf16_t* A; const bf16_t* Bt; int M, N, K; };

struct StaticOrder {
    int nM, nN, nwg, G, c;
    __host__ __device__ void init(int M, int N, int G_, int c_) { nM = M / BM; nN = N / BM; nwg = nM * nN; G = G_; c = c_; }
    __host__ __device__ bool next(int i, Unit& u) const {
        const long L = (long)i * G + c; if (L >= nwg) return false;
        int wgid = (int)L; { const int q = nwg / NXCD, r = nwg % NXCD, xcd = wgid % NXCD, off = wgid / NXCD; wgid = (xcd < r ? xcd * (q + 1) : r * (q + 1) + (xcd - r) * q) + off; }
        const int nig = WGM * nN, gid = wgid / nig, fm = gid * WGM, gsz = (nM - fm) < WGM ? (nM - fm) : WGM;
        u.pm = fm + ((wgid % nig) % gsz); u.pn = (wgid % nig) / gsz; return true;
    }
    __device__ __forceinline__ void a_ready(const Unit&) const {}
    __device__ __forceinline__ void done(const Unit&) const {}
};

__device__ __forceinline__ unsigned cvt_pk_bf16(float lo, float hi) { unsigned r; asm volatile("v_cvt_pk_bf16_f32 %0, %1, %2" : "=v"(r) : "v"(lo), "v"(hi)); return r; }
typedef float f32x2 __attribute__((ext_vector_type(2)));
typedef unsigned u32x2 __attribute__((ext_vector_type(2)));
struct EpiProj {
    static constexpr bool PERM = true, AFTER_DRAIN = false;
    bf16_t* O; int ldc; const float* ssp;
    __device__ __forceinline__ void operator()(const f32x4 (&acc)[2][2][4][2], const Unit& u, int wr, int wc, int fr, int fq) const {
        const int row0 = u.pm * BM + wr * 64 + fr, col0 = u.pn * BM + wc * 32 + 8 * fq;
#pragma unroll
        for (int ai = 0; ai < 2; ++ai)
#pragma unroll
            for (int m = 0; m < 4; ++m) {
                const int row = row0 + ai * HALF + m * 16;
                const f32x4 s = *(const f32x4*)(ssp + (size_t)row * 4);
                const float rs = rsqrtf(((s[0] + s[1]) + (s[2] + s[3])) * (1.0f / 1024.0f) + 1e-6f);
                bf16_t* rowp = O + (size_t)row * ldc + col0;
#pragma unroll
                for (int bj = 0; bj < 2; ++bj) { const f32x4 v0 = acc[ai][bj][m][0] * rs, v1 = acc[ai][bj][m][1] * rs;
                    u32x4 w; w.x = cvt_pk_bf16(v0[0], v0[1]); w.y = cvt_pk_bf16(v0[2], v0[3]); w.z = cvt_pk_bf16(v1[0], v1[1]); w.w = cvt_pk_bf16(v1[2], v1[3]);
                    *(u32x4*)(rowp + bj * HALF) = w; }
            }
    }
};
struct EpiRes {
    static constexpr bool PERM = false, AFTER_DRAIN = true;
    const float* basef; bf16_t* xb; float* ssp; int ldc; int base_bf16;
    __device__ __forceinline__ void fused(f32x4 (&acc)[2][2][4][2], const Unit& u, int wr, int wc, int fr, int fq, PG8_LAS unsigned char* lds, int wid, int lane) const {
        PG8_LAS float* P = (PG8_LAS float*)lds;
        const int col0 = u.pn * BM + wc * 32 + 4 * fq;
#pragma unroll
        for (int ai = 0; ai < 2; ++ai)
#pragma unroll
            for (int m = 0; m < 4; ++m) { const int r = ai * HALF + wr * 64 + m * 16 + fr; const size_t off = (size_t)(u.pm * BM + r) * ldc + col0; float s = 0.f;
                f32x4 bs[2][2];
                if (base_bf16) {
#pragma unroll
                    for (int bj = 0; bj < 2; ++bj)
#pragma unroll
                        for (int n = 0; n < 2; ++n) { const u32x2 w = *(const u32x2*)(xb + off + bj * HALF + n * 16);
                            bs[bj][n] = (f32x4){__uint_as_float(w.x << 16), __uint_as_float(w.x & 0xffff0000u), __uint_as_float(w.y << 16), __uint_as_float(w.y & 0xffff0000u)}; }
                } else {
#pragma unroll
                    for (int bj = 0; bj < 2; ++bj)
#pragma unroll
                        for (int n = 0; n < 2; ++n) bs[bj][n] = *(const f32x4*)(basef + off + bj * HALF + n * 16);
                }
#pragma unroll
                for (int bj = 0; bj < 2; ++bj)
#pragma unroll
                    for (int n = 0; n < 2; ++n) { const f32x4 o = bs[bj][n] + acc[ai][bj][m][n];
                        u32x2 w; w.x = cvt_pk_bf16(o[0], o[1]); w.y = cvt_pk_bf16(o[2], o[3]); *(u32x2*)(xb + off + bj * HALF + n * 16) = w;
                        s += (o[0] * o[0] + o[1] * o[1]) + (o[2] * o[2] + o[3] * o[3]); }
                s += __shfl_xor(s, 16); s += __shfl_xor(s, 32);
                if (fq == 0) P[r * 4 + wc] = s;
                if (m & 1) asm volatile("" ::: "memory"); }
        asm volatile("s_waitcnt lgkmcnt(0)" ::: "memory"); __builtin_amdgcn_s_barrier(); asm volatile("" ::: "memory");
        const int tid = wid * 64 + lane;
        if (tid < 256) { const f32x4 p = *(const PG8_LAS f32x4*)(P + tid * 4); ssp[(size_t)(u.pm * BM + tid) * 4 + u.pn] = (p[0] + p[1]) + (p[2] + p[3]); }
        asm volatile("s_waitcnt lgkmcnt(0)" ::: "memory"); __builtin_amdgcn_s_barrier(); asm volatile("" ::: "memory");
    }
};
template <class Epi, class Sched, bool ALIGN_EPI = false, bool SP2 = false>
__device__ __forceinline__ void gemm_phase(PG8_LAS unsigned char* lds, const Gemm g, const Sched& S, const Epi& E) {
    int tid_ = threadIdx.x; asm volatile("" : "+v"(tid_));
    const int tid = tid_, wid = __builtin_amdgcn_readfirstlane(tid >> 6), lane = tid & 63, wr = wid >> 2, wc = wid & 3, fr = lane & 15, fq = lane >> 4;
    const int K = g.K, nt = K / BK;
    unsigned voffA[2], voffB[2];
#pragma unroll
    for (int i = 0; i < 2; ++i) { int R, C; stage_rc(tid * 16 + i * 8192, R, C); const int Rb = Epi::PERM ? ((R & ~31) + perm32(R & 31)) : R;
        voffA[i] = (unsigned)(R * K + C) * 2u; voffB[i] = (unsigned)(Rb * K + C) * 2u; }
    const size_t kstep = (size_t)(BK * 2);
    const size_t hstep = (size_t)HALF * K * 2;
    const size_t tstep = 2 * hstep;
    const unsigned ldsw = (unsigned)wid * 1024u;
    const int aoff = lds_byte(wr * 64 + fr, fq * 8), boff = lds_byte(wc * 32 + fr, fq * 8);
#define PG8_SA(b, h) (((b) * 2 + (h)) * HTB)
#define PG8_SB(b, h) ((4 + (b) * 2 + (h)) * HTB)
#define PG8_STAGE(bufoff, gbase, voff) do { _Pragma("unroll") for (int _i = 0; _i < 2; ++_i) \
        __builtin_amdgcn_global_load_lds((const unsigned*)((const char*)(gbase) + (voff)[_i]), (PG8_LAS unsigned*)(lds + (bufoff) + ldsw + _i * 8192), 16, 0, 0); } while (0)
#define PG8_LDA(dst, b, h) do { _Pragma("unroll") for (int m = 0; m < 4; ++m) _Pragma("unroll") for (int k = 0; k < 2; ++k) dst[m][k] = *(const PG8_LAS bf16x8*)(lds + PG8_SA(b, h) + aoff + m * 2048 + k * 1024); } while (0)
#define PG8_LDB(dst, b, h) do { _Pragma("unroll") for (int n = 0; n < 2; ++n) _Pragma("unroll") for (int k = 0; k < 2; ++k) dst[n][k] = *(const PG8_LAS bf16x8*)(lds + PG8_SB(b, h) + boff + n * 2048 + k * 1024); } while (0)
#define PG8_MMA(ai, bj, At, Bt) do { __builtin_amdgcn_s_setprio(1); _Pragma("unroll") for (int m = 0; m < 4; ++m) _Pragma("unroll") for (int n = 0; n < 2; ++n) _Pragma("unroll") for (int k = 0; k < 2; ++k) \
        acc[ai][bj][m][n] = __builtin_amdgcn_mfma_f32_16x16x32_bf16(Bt[n][k], At[m][k], acc[ai][bj][m][n], 0, 0, 0); __builtin_amdgcn_s_setprio(0); } while (0)
#define PG8_WAIT_V(n) asm volatile("s_waitcnt vmcnt(" #n ")" ::: "memory")
#define PG8_WAIT_L(n) asm volatile("s_waitcnt lgkmcnt(" #n ")" ::: "memory")
#define PG8_BAR __builtin_amdgcn_s_barrier()
#define PG8_SCHED __builtin_amdgcn_sched_barrier(0)
    Unit cur, nxt; int ui = 0;
    if (!S.next(0, cur)) return;
    f32x4 acc[2][2][4][2];
#pragma unroll
    for (int a = 0; a < 2; ++a)
#pragma unroll
        for (int b = 0; b < 2; ++b)
#pragma unroll
            for (int m = 0; m < 4; ++m)
#pragma unroll
                for (int n = 0; n < 2; ++n) acc[a][b][m][n] = (f32x4){0.f, 0.f, 0.f, 0.f};
    bf16x8 At[4][2], B0[2][2], B1[2][2];
    const char* cA = (const char*)g.A + (size_t)cur.pm * tstep; const char* cB = (const char*)g.Bt + (size_t)cur.pn * tstep;
    S.a_ready(cur);
    if constexpr (SP2) {
        PG8_STAGE(PG8_SB(0, 0), cB, voffB); PG8_STAGE(PG8_SB(0, 1), cB + hstep, voffB); PG8_STAGE(PG8_SA(0, 0), cA, voffA); PG8_STAGE(PG8_SA(0, 1), cA + hstep, voffA);
        if (wr == 1) PG8_BAR;
        PG8_WAIT_V(2); PG8_BAR;
        PG8_STAGE(PG8_SB(1, 0), cB + kstep, voffB); PG8_STAGE(PG8_SA(1, 0), cA + kstep, voffA); PG8_STAGE(PG8_SB(1, 1), cB + hstep + kstep, voffB);
        PG8_WAIT_V(6); PG8_BAR;
    } else {
        PG8_STAGE(PG8_SB(0, 0), cB, voffB); PG8_STAGE(PG8_SA(0, 0), cA, voffA); PG8_STAGE(PG8_SB(0, 1), cB + hstep, voffB); PG8_STAGE(PG8_SA(0, 1), cA + hstep, voffA);
        if (wr == 1) PG8_BAR;
        PG8_WAIT_V(4); PG8_BAR;
        PG8_STAGE(PG8_SB(1, 0), cB + kstep, voffB); PG8_STAGE(PG8_SA(1, 0), cA + kstep, voffA); PG8_STAGE(PG8_SB(1, 1), cB + hstep + kstep, voffB);
        PG8_WAIT_V(6); PG8_BAR;
    }
    for (;;) {
        const bool has_next = S.next(ui + 1, nxt);
        const char* nA = has_next ? (const char*)g.A + (size_t)nxt.pm * tstep : cA; const char* nB = has_next ? (const char*)g.Bt + (size_t)nxt.pn * tstep : cB;
        for (int t = 0; t < nt; t += 2) {
            const bool last = (t == nt - 2);
            const char* a1 = cA + (size_t)(t + 1) * kstep;
            const char* a2 = last ? nA : cA + (size_t)(t + 2) * kstep; const char* b2 = last ? nB : cB + (size_t)(t + 2) * kstep;
            const char* a3 = a2 + kstep; const char* b3 = b2 + kstep;
            if (last && has_next) S.a_ready(nxt);
            if constexpr (SP2) {
            PG8_LDB(B0, 0, 0); PG8_LDB(B1, 0, 1); PG8_SCHED; PG8_LDA(At, 0, 0); PG8_STAGE(PG8_SA(1, 1), a1 + hstep, voffA);
            PG8_WAIT_V(8); PG8_WAIT_L(0); PG8_BAR; PG8_MMA(0, 0, At, B0); PG8_MMA(0, 1, At, B1); PG8_BAR; PG8_SCHED;
            PG8_LDA(At, 0, 1); PG8_STAGE(PG8_SB(0, 0), b2, voffB); PG8_STAGE(PG8_SB(0, 1), b2 + hstep, voffB); PG8_STAGE(PG8_SA(0, 0), a2, voffA);
            PG8_WAIT_V(8); PG8_WAIT_L(0); PG8_BAR; PG8_MMA(1, 0, At, B0); PG8_MMA(1, 1, At, B1); PG8_BAR; PG8_SCHED;
            PG8_LDB(B0, 1, 0); PG8_LDB(B1, 1, 1); PG8_SCHED; PG8_LDA(At, 1, 0); PG8_STAGE(PG8_SA(0, 1), a2 + hstep, voffA);
            PG8_WAIT_V(8); PG8_WAIT_L(0); PG8_BAR; PG8_MMA(0, 0, At, B0); PG8_MMA(0, 1, At, B1); PG8_BAR; PG8_SCHED;
            PG8_LDA(At, 1, 1); PG8_STAGE(PG8_SB(1, 0), b3, voffB); PG8_STAGE(PG8_SB(1, 1), b3 + hstep, voffB); PG8_STAGE(PG8_SA(1, 0), a3, voffA);
            PG8_WAIT_V(8); PG8_WAIT_L(0); PG8_BAR; PG8_MMA(1, 0, At, B0); PG8_MMA(1, 1, At, B1); PG8_BAR; PG8_SCHED;
            } else {
            PG8_LDB(B0, 0, 0); PG8_SCHED; PG8_LDA(At, 0, 0); PG8_STAGE(PG8_SA(1, 1), a1 + hstep, voffA);
            PG8_WAIT_L(8); PG8_BAR; PG8_WAIT_L(0); PG8_MMA(0, 0, At, B0); PG8_BAR; PG8_SCHED;
            PG8_LDB(B1, 0, 1); PG8_STAGE(PG8_SB(0, 0), b2, voffB);
            PG8_BAR; PG8_WAIT_L(0); PG8_MMA(0, 1, At, B1); PG8_BAR;
            PG8_LDA(At, 0, 1); PG8_STAGE(PG8_SA(0, 0), a2, voffA);
            PG8_BAR; PG8_WAIT_L(0); PG8_MMA(1, 0, At, B0); PG8_BAR; PG8_SCHED;
            PG8_STAGE(PG8_SB(0, 1), b2 + hstep, voffB);
            PG8_WAIT_V(6); PG8_BAR; PG8_MMA(1, 1, At, B1); PG8_BAR;
            PG8_LDB(B0, 1, 0); PG8_SCHED; PG8_LDA(At, 1, 0); PG8_STAGE(PG8_SA(0, 1), a2 + hstep, voffA);
            PG8_WAIT_L(8); PG8_BAR; PG8_WAIT_L(0); PG8_MMA(0, 0, At, B0); PG8_BAR; PG8_SCHED;
            PG8_LDB(B1, 1, 1); PG8_STAGE(PG8_SB(1, 0), b3, voffB);
            PG8_BAR; PG8_WAIT_L(0); PG8_MMA(0, 1, At, B1); PG8_BAR;
            PG8_LDA(At, 1, 1); PG8_STAGE(PG8_SA(1, 0), a3, voffA);
            PG8_BAR; PG8_WAIT_L(0); PG8_MMA(1, 0, At, B0); PG8_BAR; PG8_SCHED;
            PG8_STAGE(PG8_SB(1, 1), b3 + hstep, voffB);
            PG8_WAIT_V(6); PG8_BAR; PG8_MMA(1, 1, At, B1); PG8_BAR;
            }
        }
        if constexpr (ALIGN_EPI) { if (wr == 0) PG8_BAR; }
        if constexpr (!Epi::AFTER_DRAIN) { E(acc, cur, wr, wc, fr, fq); S.done(cur); }
        if (!has_next) break;
#pragma unroll
        for (int a = 0; a < 2; ++a)
#pragma unroll
            for (int b = 0; b < 2; ++b)
#pragma unroll
                for (int m = 0; m < 4; ++m)
#pragma unroll
                    for (int n = 0; n < 2; ++n) acc[a][b][m][n] = (f32x4){0.f, 0.f, 0.f, 0.f};
        cur = nxt; cA = nA; cB = nB; ++ui;
        if constexpr (ALIGN_EPI) { if (wr == 1) PG8_BAR; }
    }
    PG8_WAIT_V(0);
    if constexpr (!ALIGN_EPI) { if (wr == 0) PG8_BAR; }
    PG8_BAR;
    if constexpr (Epi::AFTER_DRAIN) { E.fused(acc, cur, wr, wc, fr, fq, lds, wid, lane); S.done(cur); }
#undef PG8_SA
#undef PG8_SB
#undef PG8_STAGE
#undef PG8_LDA
#undef PG8_LDB
#undef PG8_MMA
#undef PG8_WAIT_V
#undef PG8_WAIT_L
#undef PG8_BAR
#undef PG8_SCHED
}
}
constexpr int NWAVES = 8;
#ifndef MK_N_LAUNCHES
#define MK_N_LAUNCHES 1
#endif
#ifndef PROBE_DUP
#define PROBE_DUP -1
#endif
#ifndef PROBE_XBAR
#define PROBE_XBAR 0
#endif
constexpr int N_LAUNCHES = MK_N_LAUNCHES;
constexpr int NPH = 8;
constexpr int D = 1024, BATCH = 2, SEQ = 8192, M = BATCH * SEQ, DIN = 2560, DEPTH = 2;
constexpr int C_UPOOL = 0, C_GPOOL = 256, C_CA = 512, C_CB = 768, C_GCONV = 1024, C_Q = 1280, C_K = 1792, C_V = 1920, C_GATTN = 2048;
constexpr float EPS = 1e-6f;
constexpr size_t MiB = 1u << 20;
constexpr size_t WS_CTL = 0, CTL_ZERO_BYTES = 1 * MiB;
constexpr size_t WS_WIN = 2 * MiB;
constexpr size_t WS_WOUT = 12 * MiB;
constexpr size_t WS_WPW = 16 * MiB;
constexpr size_t WS_WPOOL = 16 * MiB + 512 * 1024;
constexpr size_t WS_SSP = 17 * MiB;
constexpr size_t WS_XB = 32 * MiB;
constexpr size_t WS_PROJ = 64 * MiB;
constexpr size_t WS_Y = 144 * MiB;
constexpr size_t WS_END = 176 * MiB;
constexpr int CW_BAR = 4096;
constexpr int RING_OFF = 0, RING_BYTES = 131072, LDSCTL_OFF = 146432, MISC_OFF = LDSCTL_OFF + 320, LDS_BYTES = 147456;
#define GAS __attribute__((address_space(1)))
#define LAS __attribute__((address_space(3)))
typedef unsigned short bf16;
typedef unsigned v4u __attribute__((ext_vector_type(4)));
typedef float f32x4 __attribute__((ext_vector_type(4)));
typedef short bf16x8 __attribute__((ext_vector_type(8)));
typedef GAS unsigned gu32;
typedef GAS unsigned long long gu64;
#define RLX_AGENT __ATOMIC_RELAXED, __HIP_MEMORY_SCOPE_AGENT
#define LDS_WAIT() asm volatile("s_waitcnt lgkmcnt(0)" ::: "memory")
#define VM_WAIT() asm volatile("s_waitcnt vmcnt(0)" ::: "memory")
__device__ __forceinline__ unsigned long long rt() { return __builtin_amdgcn_s_memrealtime(); }
__device__ __forceinline__ unsigned f2bf(float f) { unsigned u = __builtin_bit_cast(unsigned, f); return (u + 0x7fffu + ((u >> 16) & 1u)) >> 16; }
__device__ __forceinline__ unsigned pk2(float lo, float hi) { return f2bf(lo) | (f2bf(hi) << 16); }
#define XB_TMO      128
#define XB_XCNT(j)  (256  + 64 * (j))
#define XB_XSUB(j)  (1280 + 64 * (j))
#define XB_XGEN(j)  (2304 + 64 * (j))
#define XB_TOP      3328
#define XB_TOPGEN   3392
#define XCD_BAR_WORDS 3456
#define XB_SPIN_CAP (1u << 18)

__device__ __forceinline__ unsigned xb_ld(unsigned* p)              { return __hip_atomic_load(p, __ATOMIC_RELAXED, __HIP_MEMORY_SCOPE_AGENT); }
__device__ __forceinline__ unsigned xb_add(unsigned* p, unsigned v) { return __hip_atomic_fetch_add(p, v, __ATOMIC_RELAXED, __HIP_MEMORY_SCOPE_AGENT); }
__device__ __forceinline__ unsigned xb_xcc_id() { return (unsigned)__builtin_amdgcn_s_getreg((3 << 11) | 20) & 0xFu; }
#define XB_SPIN(cond, bar) do { unsigned _sp = 0; while (cond) { __builtin_amdgcn_s_sleep(1); \
    if ((++_sp & 255u) == 0u) { if (xb_ld(&(bar)[XB_TMO])) break; if (_sp > XB_SPIN_CAP) { atomicAdd(&(bar)[XB_TMO], 1u); break; } } } } while (0)

struct XcdBarrier {
    unsigned* bar; unsigned x;
    volatile LAS unsigned* st;
};

__device__ __forceinline__ XcdBarrier xcd_barrier_post(unsigned* bar, volatile LAS unsigned* st) {
    XcdBarrier b; b.bar = bar; b.x = xb_xcc_id(); b.st = st;
    if (threadIdx.x == 0) (void)xb_add(&bar[XB_XCNT(b.x)], 1u);
    return b;
}
__device__ __forceinline__ void xcd_barrier_complete(unsigned* bar, unsigned x, unsigned& nloc, unsigned& nx) {
    const unsigned G = gridDim.x * gridDim.y * gridDim.z;
    unsigned sum, cnt, mine, sp = 0u;
    for (;;) {
        sum = 0u; cnt = 0u; mine = 0u;
#pragma unroll
        for (unsigned j = 0; j < 16; ++j) { const unsigned c = xb_ld(&bar[XB_XCNT(j)]); sum += c; cnt += (c > 0u) ? 1u : 0u; mine = (j == x) ? c : mine; }
        if (sum == G) break;
        __builtin_amdgcn_s_sleep(1);
        if ((++sp & 255u) == 0u) { if (xb_ld(&bar[XB_TMO])) break; if (sp > XB_SPIN_CAP) { atomicAdd(&bar[XB_TMO], 1u); break; } }
    }
    nloc = mine > 0u ? mine : 1u; nx = cnt > 0u ? cnt : 1u;
}

__device__ __forceinline__ void xcd_barrier(const XcdBarrier& b) {
    asm volatile("s_waitcnt vmcnt(0)" ::: "memory");
    __syncthreads();
    if (threadIdx.x == 0) {
        unsigned* bar = b.bar;
        __builtin_amdgcn_s_waitcnt(0);
        unsigned nloc = b.st[0], nx = b.st[1];
        if (nloc == 0u) { xcd_barrier_complete(bar, b.x, nloc, nx); b.st[0] = nloc; b.st[1] = nx; }
        const unsigned old = xb_add(&bar[XB_XSUB(b.x)], 1u);
        const unsigned gen = old / nloc;
        if (old + 1u == (gen + 1u) * nloc) {
            __builtin_amdgcn_fence(__ATOMIC_RELEASE, "agent");
            asm volatile("s_waitcnt vmcnt(0)" ::: "memory");
            const unsigned og = xb_add(&bar[XB_TOP], 1u);
            const unsigned tg = og / nx;
            if (og + 1u == (tg + 1u) * nx) xb_add(&bar[XB_TOPGEN], 1u);
            else XB_SPIN(xb_ld(&bar[XB_TOPGEN]) == tg, bar);
            __builtin_amdgcn_fence(__ATOMIC_ACQUIRE, "agent");
            xb_add(&bar[XB_XGEN(b.x)], 1u);
            asm volatile("s_waitcnt vmcnt(0)" ::: "memory");
        } else {
            XB_SPIN(xb_ld(&bar[XB_XGEN(b.x)]) == gen, bar);
            __builtin_amdgcn_fence(__ATOMIC_ACQUIRE, "agent");
            asm volatile("s_waitcnt vmcnt(0)" ::: "memory");
        }
    }
    __syncthreads();
}
typedef float f32x16 __attribute__((ext_vector_type(16)));
typedef short s16x4 __attribute__((ext_vector_type(4)));
typedef float f32x2_t __attribute__((ext_vector_type(2)));
typedef __bf16 bf16x2_t __attribute__((ext_vector_type(2)));
#define MFMA32(a, b, c) __builtin_amdgcn_mfma_f32_32x32x16_bf16((a), (b), (c), 0, 0, 0)
__device__ __forceinline__ int crow(int r, int hi) { return (r & 3) + 8 * (r >> 2) + 4 * hi; }
__device__ __forceinline__ unsigned cvtpk(float lo, float hi) { f32x2_t v = {lo, hi}; bf16x2_t b = __builtin_convertvector(v, bf16x2_t); return __builtin_bit_cast(unsigned, b); }
__device__ __forceinline__ float bflo(unsigned w) { return __uint_as_float(w << 16); }
__device__ __forceinline__ float bfhi(unsigned w) { return __uint_as_float(w & 0xffff0000u); }
__device__ __forceinline__ float fsilu(float x) { return x * __builtin_amdgcn_rcpf(1.f + __builtin_amdgcn_exp2f(-1.4426950408889634f * x)); }
__device__ __forceinline__ float fsigm(float x) { return __builtin_amdgcn_rcpf(1.f + __builtin_amdgcn_exp2f(-1.4426950408889634f * x)); }
__device__ __forceinline__ bf16x8 packP(const f32x16& p, int s) {
    v4u w; w.x = cvtpk(p[8 * s], p[8 * s + 1]); w.y = cvtpk(p[8 * s + 2], p[8 * s + 3]); w.z = cvtpk(p[8 * s + 4], p[8 * s + 5]); w.w = cvtpk(p[8 * s + 6], p[8 * s + 7]);
    return __builtin_bit_cast(bf16x8, w);
}
constexpr int STG_LD = 36;
constexpr int BL_STG = 0, BL_INVL = 8 * 32 * STG_LD * 4, BL_R1 = BL_INVL + 1024;
constexpr int AST = 528;
constexpr int CV_GLU = BL_R1, CV_HN = BL_R1, CV_OUT = BL_R1 + 62 * 1024;
constexpr int PL_U = BL_R1, PL_DIFF = BL_R1 + 47 * 1024;
constexpr int AT_K = BL_R1, AT_V = BL_R1 + 32768;
static_assert(CV_OUT + 32768 <= 146432 && PL_DIFF + 32 * AST <= 146432 && AT_V + 32768 <= 146432, "mixer LDS map");

__device__ __forceinline__ void gate_load(v4u (&gq)[2], const bf16* gate, int lane) {
#pragma unroll
    for (int it = 0; it < 2; ++it) { const int idx = it * 64 + lane, row = idx >> 2, c8 = (idx & 3) * 8; gq[it] = *(const GAS v4u*)(gate + (size_t)row * DIN + c8); }
}
__device__ __forceinline__ void tile_out(const f32x16& acc, float colscale, LAS float* stg, const LAS float* rowscale, const v4u (&gq)[2], bf16* yp, int lane) {
    const int r32 = lane & 31, hi = lane >> 5;
#pragma unroll
    for (int reg = 0; reg < 16; ++reg) stg[crow(reg, hi) * STG_LD + r32] = acc[reg] * colscale;
#pragma unroll
    for (int it = 0; it < 2; ++it) {
        const int idx = it * 64 + lane, row = idx >> 2, c8 = (idx & 3) * 8;
        f32x4 v0 = *(const LAS f32x4*)(stg + row * STG_LD + c8), v1 = *(const LAS f32x4*)(stg + row * STG_LD + c8 + 4);
        if (rowscale) { const float rs = rowscale[row]; v0 = v0 * rs; v1 = v1 * rs; }
        v4u o;
        o.x = cvtpk(v0[0] * fsilu(bflo(gq[it].x)), v0[1] * fsilu(bfhi(gq[it].x)));
        o.y = cvtpk(v0[2] * fsilu(bflo(gq[it].y)), v0[3] * fsilu(bfhi(gq[it].y)));
        o.z = cvtpk(v1[0] * fsilu(bflo(gq[it].z)), v1[1] * fsilu(bfhi(gq[it].z)));
        o.w = cvtpk(v1[2] * fsilu(bflo(gq[it].w)), v1[3] * fsilu(bfhi(gq[it].w)));
        *(GAS v4u*)(yp + (size_t)row * D + c8) = o;
    }
}

struct MixW { const float *pool_scale, *dw, *cb, *lg, *lb, *sinks; const bf16 *wpw, *wpool; };

__device__ __forceinline__ void conv_unit(LAS unsigned char* L, const bf16* PROJ, bf16* Y, const MixW& W, int tok0, int tid, int lane, int wave) {
    LAS float* GLU = (LAS float*)(L + CV_GLU); LAS float* CO = (LAS float*)(L + CV_OUT); LAS unsigned char* HN = L + CV_HN;
    const int t0 = tok0 & (SEQ - 1);
    v4u gq[2]; gate_load(gq, PROJ + (size_t)tok0 * DIN + C_GCONV + 32 * wave, lane);
    float w[31];
#pragma unroll
    for (int j = 0; j < 31; ++j) w[j] = W.dw[j * 256 + (tid & 255)];
    const float bias = W.cb[tid & 255];
    {
        v4u av[4], bv[4];
#pragma unroll
        for (int i = 0; i < 4; ++i) { const int e = tid + 512 * i, r = e >> 5, c8 = (e & 31) * 8;
            av[i] = (v4u){0u, 0u, 0u, 0u}; bv[i] = av[i];
            if (e < 62 * 32 && t0 - 30 + r >= 0) { const bf16* pr = PROJ + (size_t)(tok0 - 30 + r) * DIN; av[i] = *(const GAS v4u*)(pr + C_CA + c8); bv[i] = *(const GAS v4u*)(pr + C_CB + c8); } }
#pragma unroll
        for (int i = 0; i < 4; ++i) { const int e = tid + 512 * i, r = e >> 5, c8 = (e & 31) * 8;
            if (e < 62 * 32) { const v4u a = av[i], b = bv[i]; f32x4 g0, g1;
                g0[0] = bflo(a.x) * fsigm(bflo(b.x)); g0[1] = bfhi(a.x) * fsigm(bfhi(b.x)); g0[2] = bflo(a.y) * fsigm(bflo(b.y)); g0[3] = bfhi(a.y) * fsigm(bfhi(b.y));
                g1[0] = bflo(a.z) * fsigm(bflo(b.z)); g1[1] = bfhi(a.z) * fsigm(bfhi(b.z)); g1[2] = bflo(a.w) * fsigm(bflo(b.w)); g1[3] = bfhi(a.w) * fsigm(bfhi(b.w));
                *(LAS f32x4*)(GLU + r * 256 + c8) = g0; *(LAS f32x4*)(GLU + r * 256 + c8 + 4) = g1; } }
    }
    __syncthreads();
    const int tk = tid >> 4, part = tid & 15;
    f32x4 lgv[4], lbv[4];
#pragma unroll
    for (int i = 0; i < 4; ++i) { const int c = 64 * i + 4 * part; lgv[i] = *(const GAS f32x4*)(W.lg + c); lbv[i] = *(const GAS f32x4*)(W.lb + c); }
    {
        const int c = tid & 255, th = tid >> 8;
#pragma unroll
        for (int grp = 0; grp < 2; ++grp) {
            const int o0 = 16 * th + 8 * grp;
            float in[38];
#pragma unroll
            for (int k = 0; k < 38; ++k) in[k] = GLU[(o0 + k) * 256 + c];
#pragma unroll
            for (int o = 0; o < 8; ++o) { float a = bias;
#pragma unroll
                for (int j = 0; j < 31; ++j) a += w[j] * in[o + j];
                CO[(o0 + o) * 256 + c] = a; }
        }
    }
    __syncthreads();
    const int r32 = lane & 31, hi = lane >> 5;
    bf16x8 bfr[16];
    {
        const bf16* wrow = W.wpw + (size_t)(32 * wave + r32) * 256 + 8 * hi;
#pragma unroll
        for (int s = 0; s < 16; ++s) bfr[s] = *(const GAS bf16x8*)(wrow + 16 * s);
    }
    {
        f32x4 v[4]; float s = 0.f;
#pragma unroll
        for (int i = 0; i < 4; ++i) { v[i] = *(const LAS f32x4*)(CO + tk * 256 + 64 * i + 4 * part); s += (v[i][0] + v[i][1]) + (v[i][2] + v[i][3]); }
        s += __shfl_xor(s, 1); s += __shfl_xor(s, 2); s += __shfl_xor(s, 4); s += __shfl_xor(s, 8);
        const float mu = s * (1.f / 256.f); float q = 0.f;
#pragma unroll
        for (int i = 0; i < 4; ++i) { v[i] = v[i] - mu; q += (v[i][0] * v[i][0] + v[i][1] * v[i][1]) + (v[i][2] * v[i][2] + v[i][3] * v[i][3]); }
        q += __shfl_xor(q, 1); q += __shfl_xor(q, 2); q += __shfl_xor(q, 4); q += __shfl_xor(q, 8);
        const float rstd = rsqrtf(q * (1.f / 256.f) + EPS);
#pragma unroll
        for (int i = 0; i < 4; ++i) { const int c = 64 * i + 4 * part;
            const f32x4 y = v[i] * rstd * lgv[i] + lbv[i];
            pg8::u32x2 o; o.x = cvtpk(fsilu(y[0]), fsilu(y[1])); o.y = cvtpk(fsilu(y[2]), fsilu(y[3]));
            *(LAS pg8::u32x2*)(HN + tk * AST + c * 2) = o; }
    }
    __syncthreads();
    {
        f32x16 acc = {};
#pragma unroll
        for (int s = 0; s < 16; ++s) { const bf16x8 a = *(const LAS bf16x8*)(HN + r32 * AST + (16 * s + 8 * hi) * 2); acc = MFMA32(a, bfr[s], acc); }
        tile_out(acc, 1.f, (LAS float*)(L + BL_STG) + wave * 32 * STG_LD, nullptr, gq, Y + (size_t)tok0 * D + 256 + 32 * wave, lane);
    }
    __syncthreads();
}

__device__ __forceinline__ void pool_unit(LAS unsigned char* L, const bf16* PROJ, bf16* Y, const MixW& W, int tok0, int tid, int lane, int wave) {
    LAS float* U = (LAS float*)(L + PL_U); LAS unsigned char* DF = L + PL_DIFF;
    const int t0 = tok0 & (SEQ - 1);
    v4u gq[2]; gate_load(gq, PROJ + (size_t)tok0 * DIN + C_GPOOL + 32 * wave, lane);
    bf16x8 bfr[4];
    { const bf16* wrow = W.wpool + (size_t)(wave >> 1) * 4096 + (size_t)(32 * (wave & 1) + (lane & 31)) * 64 + 8 * (lane >> 5);
#pragma unroll
      for (int s = 0; s < 4; ++s) bfr[s] = *(const GAS bf16x8*)(wrow + 16 * s); }
    const float pscale = W.pool_scale[32 * wave + (lane & 31)];
    {
        v4u av[3];
#pragma unroll
        for (int i = 0; i < 3; ++i) { const int e = tid + 512 * i, r = e >> 5, c8 = (e & 31) * 8;
            av[i] = (v4u){0u, 0u, 0u, 0u};
            if (e < 47 * 32 && t0 - 15 + r >= 0) av[i] = *(const GAS v4u*)(PROJ + (size_t)(tok0 - 15 + r) * DIN + C_UPOOL + c8); }
#pragma unroll
        for (int i = 0; i < 3; ++i) { const int e = tid + 512 * i, r = e >> 5, c8 = (e & 31) * 8;
            if (e < 47 * 32) { const v4u a = av[i]; f32x4 g0, g1;
                g0[0] = bflo(a.x); g0[1] = bfhi(a.x); g0[2] = bflo(a.y); g0[3] = bfhi(a.y); g1[0] = bflo(a.z); g1[1] = bfhi(a.z); g1[2] = bflo(a.w); g1[3] = bfhi(a.w);
                *(LAS f32x4*)(U + r * 256 + c8) = g0; *(LAS f32x4*)(U + r * 256 + c8 + 4) = g1; } }
    }
    __syncthreads();
    {
        const int c = tid & 255, th = tid >> 8, g = wave & 3, wnd = 2 << g;
        const int R0 = 16 * th + 15;
        float s = 0.f;
        for (int k = 0; k < wnd; ++k) s += U[(R0 - k) * 256 + c];
#pragma unroll 4
        for (int o = 0; o < 16; ++o) {
            const int tp = t0 + 16 * th + o; const int cnt = (tp + 1 < wnd) ? tp + 1 : wnd;
            const float uv = U[(R0 + o) * 256 + c];
            const float df = s * __builtin_amdgcn_rcpf((float)cnt) - uv;
            *(LAS bf16*)(DF + (16 * th + o) * AST + c * 2) = (bf16)(cvtpk(df, 0.f) & 0xffffu);
            if (o < 15) s += U[(R0 + o + 1) * 256 + c] - U[(R0 + o + 1 - wnd) * 256 + c];
        }
    }
    __syncthreads();
    {
        const int r32 = lane & 31, hi = lane >> 5, g = wave >> 1;
        f32x16 acc = {};
#pragma unroll
        for (int s = 0; s < 4; ++s) { const bf16x8 a = *(const LAS bf16x8*)(DF + r32 * AST + (64 * g + 16 * s + 8 * hi) * 2); acc = MFMA32(a, bfr[s], acc); }
        tile_out(acc, pscale, (LAS float*)(L + BL_STG) + wave * 32 * STG_LD, nullptr, gq, Y + (size_t)tok0 * D + 32 * wave, lane);
    }
    __syncthreads();
}

__device__ __forceinline__ void attn_unit(LAS unsigned char* L, const bf16* PROJ, bf16* Y, const MixW& W, int unit, int tid, int lane, int wave) {
    const int n = unit & 63, kvh = (unit >> 6) & 1, b = unit >> 7;
    const int tokq0 = b * SEQ + n * 128;
    LAS unsigned char* KL = L + AT_K; LAS unsigned char* VL = L + AT_V;
    const int r32 = lane & 31, hi = lane >> 5;
    const int hq = kvh * 4 + (wave >> 1);
    {
        v4u kq[4], vq[4];
#pragma unroll
        for (int i = 0; i < 4; ++i) { const int e = tid + 512 * i, j = e >> 3, ch = e & 7;
            kq[i] = (v4u){0u, 0u, 0u, 0u}; vq[i] = kq[i];
            if (n > 0 || j >= 128) { const bf16* pr = PROJ + (size_t)(tokq0 - 128 + j) * DIN + kvh * 64 + ch * 8; kq[i] = *(const GAS v4u*)(pr + C_K); vq[i] = *(const GAS v4u*)(pr + C_V); } }
#pragma unroll
        for (int i = 0; i < 4; ++i) { const int e = tid + 512 * i, j = e >> 3, ch = e & 7;
            *(LAS v4u*)(KL + j * 128 + ((ch ^ (j & 7)) << 4)) = kq[i];
            *(LAS v4u*)(VL + j * 128 + ((ch ^ (((j >> 1) & 1) << 2)) << 4)) = vq[i]; }
    }
    __syncthreads();
    const float slope2 = exp2f(-(float)(hq + 1)) * 1.4426950408889634f, sink2 = W.sinks[hq] * 1.4426950408889634f;
    const float c1 = 0.125f * 1.4426950408889634f;
    LAS float* stg = (LAS float*)(L + BL_STG) + wave * 32 * STG_LD;
    LAS float* invl = (LAS float*)(L + BL_INVL) + wave * 32;
#pragma unroll 1
    for (int blk = 0; blk < 2; ++blk) {
        const int i0 = (wave & 1) * 64 + blk * 32, jt0 = i0 >> 5;
        bf16x8 qf[4]; v4u gq[2][2];
        {
            const bf16* qrow = PROJ + (size_t)(tokq0 + i0 + r32) * DIN + C_Q + hq * 64 + 8 * hi;
#pragma unroll
            for (int s = 0; s < 4; ++s) qf[s] = *(const GAS bf16x8*)(qrow + 16 * s);
            const bf16* gate = PROJ + (size_t)(tokq0 + i0) * DIN + C_GATTN + hq * 64;
            gate_load(gq[0], gate, lane); gate_load(gq[1], gate + 32, lane);
        }
        f32x16 p[5];
        float mx = sink2;
#pragma unroll
        for (int d = 0; d < 5; ++d) {
            const int jt = jt0 + d;
            f32x16 a = {};
#pragma unroll
            for (int s = 0; s < 4; ++s) { const int key = 32 * jt + r32; const bf16x8 kf = *(const LAS bf16x8*)(KL + key * 128 + (((2 * s + hi) ^ (key & 7)) << 4)); a = MFMA32(kf, qf[s], a); }
            const bool tile_ok = (n > 0) || (jt >= 4);
            const float distb = (float)(128 + i0 + r32 - 32 * jt - 4 * hi);
#pragma unroll
            for (int reg = 0; reg < 16; ++reg) {
                const float dist = distb - (float)((reg & 3) + 8 * (reg >> 2));
                const float v = a[reg] * c1 - slope2 * dist;
                const bool ok = tile_ok && dist >= 0.f && dist < 128.f;
                a[reg] = ok ? v : -1e30f;
                mx = fmaxf(mx, a[reg]);
            }
            p[d] = a;
        }
        mx = fmaxf(mx, __shfl_xor(mx, 32));
        float lsum = 0.f;
#pragma unroll
        for (int d = 0; d < 5; ++d)
#pragma unroll
            for (int reg = 0; reg < 16; ++reg) { const float e = __builtin_amdgcn_exp2f(p[d][reg] - mx); p[d][reg] = e; lsum += e; }
        lsum += __shfl_xor(lsum, 32);
        lsum += __builtin_amdgcn_exp2f(sink2 - mx);
        if (hi == 0) invl[r32] = __builtin_amdgcn_rcpf(lsum);
        f32x16 o0 = {}, o1 = {};
        const int q4 = (lane & 15) >> 2, p4 = lane & 3, g2 = (lane >> 4) & 1;
#pragma unroll
        for (int d = 0; d < 5; ++d) {
            const int jt = jt0 + d;
#pragma unroll
            for (int s = 0; s < 2; ++s) {
                const bf16x8 pa = packP(p[d], s);
                const int keyA = 32 * jt + 16 * s + 4 * hi + q4, keyB = keyA + 8;
                const int offA = keyA * 128 + 32 * g2 + 8 * p4, offB = keyB * 128 + 32 * g2 + 8 * p4;
                const int swA = ((keyA >> 1) & 1) << 6, swB = ((keyB >> 1) & 1) << 6;
                const s16x4 a0 = __builtin_bit_cast(s16x4, __builtin_amdgcn_ds_read_tr16_b64_v4i16((LAS s16x4*)(VL + (offA ^ swA))));
                const s16x4 b0 = __builtin_bit_cast(s16x4, __builtin_amdgcn_ds_read_tr16_b64_v4i16((LAS s16x4*)(VL + (offB ^ swB))));
                const s16x4 a1 = __builtin_bit_cast(s16x4, __builtin_amdgcn_ds_read_tr16_b64_v4i16((LAS s16x4*)(VL + ((offA + 64) ^ swA))));
                const s16x4 b1 = __builtin_bit_cast(s16x4, __builtin_amdgcn_ds_read_tr16_b64_v4i16((LAS s16x4*)(VL + ((offB + 64) ^ swB))));
                const bf16x8 v0 = {a0[0], a0[1], a0[2], a0[3], b0[0], b0[1], b0[2], b0[3]}, v1 = {a1[0], a1[1], a1[2], a1[3], b1[0], b1[1], b1[2], b1[3]};
                o0 = MFMA32(pa, v0, o0); o1 = MFMA32(pa, v1, o1);
            }
        }
        bf16* yp = Y + (size_t)(tokq0 + i0) * D + 512 + hq * 64;
        tile_out(o0, 1.f, stg, invl, gq[0], yp, lane);
        tile_out(o1, 1.f, stg, invl, gq[1], yp + 32, lane);
    }
    __syncthreads();
}
__device__ __forceinline__ float bf2f(bf16 v) { return __uint_as_float((unsigned)v << 16); }
__device__ __forceinline__ float wave_sum(float v) {
#pragma unroll
    for (int o = 1; o < 64; o <<= 1) v += __shfl_xor(v, o);
    return v;
}
__device__ __forceinline__ float silu_f(float x) { return x / (1.f + __expf(-x)); }
__device__ __forceinline__ float sigmoid_f(float x) { return 1.f / (1.f + __expf(-x)); }

__device__ __forceinline__ void p0_transpose_item(const float* W, int K, int N, bf16* WT, LAS float* scr, int item, int lane, const float* kscale) {
    const int nblk = N / 32, kb = item / nblk, nb = item % nblk, k0 = 64 * kb, n0 = 32 * nb;
    const int c = lane & 7;
    f32x4 v[8], ks0 = {1.f, 1.f, 1.f, 1.f}, ks1 = ks0;
#pragma unroll
    for (int i = 0; i < 8; ++i) v[i] = *(const GAS f32x4*)(W + (size_t)(k0 + 8 * i + (lane >> 3)) * N + n0 + 4 * c);
    if (kscale) { ks0 = *(const GAS f32x4*)(kscale + k0 + 8 * c); ks1 = *(const GAS f32x4*)(kscale + k0 + 8 * c + 4); }
#pragma unroll
    for (int i = 0; i < 8; ++i) { LAS float* d = scr + (8 * i + (lane >> 3)) * 33 + 4 * c; d[0] = v[i][0]; d[1] = v[i][1]; d[2] = v[i][2]; d[3] = v[i][3]; }
    LDS_WAIT(); asm volatile("" ::: "memory");
#pragma unroll
    for (int j = 0; j < 4; ++j) { const int n = (lane >> 3) + 8 * j; const LAS float* s = scr + (8 * c) * 33 + n;
        v4u o; o.x = pk2(s[0 * 33] * ks0[0], s[1 * 33] * ks0[1]); o.y = pk2(s[2 * 33] * ks0[2], s[3 * 33] * ks0[3]); o.z = pk2(s[4 * 33] * ks1[0], s[5 * 33] * ks1[1]); o.w = pk2(s[6 * 33] * ks1[2], s[7 * 33] * ks1[3]);
        *(GAS v4u*)(WT + (size_t)(n0 + n) * K + k0 + 8 * c) = o; }
    LDS_WAIT(); asm volatile("" ::: "memory");
}

struct Args { const float* in[13]; float* out; unsigned char* ws; int ph_lo, ph_hi; };

__global__ void __launch_bounds__(NWAVES * 64, 2) fwd(Args args) {
    extern __shared__ __attribute__((aligned(16))) unsigned char lds[];
    LAS unsigned char* L = (LAS unsigned char*)lds;
    volatile LAS unsigned* MISC = (volatile LAS unsigned*)(L + MISC_OFF);
    const int tid = threadIdx.x, lane = tid & 63, wave = __builtin_amdgcn_readfirstlane(tid >> 6);
    const int G = gridDim.x;
    unsigned char* ws = args.ws;
    gu32* ctl = (gu32*)(ws + WS_CTL);
    const float* x = args.in[0]; const float* ln_g = args.in[1]; const float* w_in = args.in[2]; const float* pool_w = args.in[3]; const float* pool_scale = args.in[4];
    const float* conv_dw = args.in[5]; const float* conv_b = args.in[6]; const float* conv_ln_g = args.in[7]; const float* conv_ln_b = args.in[8]; const float* conv_pw = args.in[9];
    const float* attn_sinks = args.in[10]; const float* w_out = args.in[11]; const float* final_g = args.in[12];
    float* out = args.out;
    bf16* WIN = (bf16*)(ws + WS_WIN); bf16* WOUT = (bf16*)(ws + WS_WOUT); bf16* WPW = (bf16*)(ws + WS_WPW); bf16* WPOOL = (bf16*)(ws + WS_WPOOL);
    float* SSP = (float*)(ws + WS_SSP); bf16* XB = (bf16*)(ws + WS_XB); bf16* PROJ = (bf16*)(ws + WS_PROJ); bf16* Y = (bf16*)(ws + WS_Y);
    for (int u = tid; u < (LDS_BYTES - LDSCTL_OFF) / 4; u += NWAVES * 64) ((LAS unsigned*)(L + LDSCTL_OFF))[u] = 0u;
    __syncthreads();
    XcdBarrier bar; bar.bar = (unsigned*)(ctl + CW_BAR); bar.x = 0; bar.st = nullptr;
    if (N_LAUNCHES == 1) bar = xcd_barrier_post((unsigned*)(ctl + CW_BAR), MISC + 8);
    const int lo = args.ph_lo, hi = args.ph_hi;
#define IN(k) (lo <= (k) && (k) < hi)
#define SEAM(k) do { if (IN(k) && IN((k) + 1)) xcd_barrier(bar); } while (0)
#define REPS(k) ((PROBE_DUP == (k)) ? 2 : 1)

    for (int rep = 0; rep < REPS(0); ++rep) { if (rep) xcd_barrier(bar);
    if (IN(0)) {
        LAS float* scr = (LAS float*)(L + RING_OFF + wave * 16384);
        const int gw = blockIdx.x * NWAVES + wave, NGW = G * NWAVES;
        constexpr int I_IN = (D / 64) * (DIN / 32), I_OUT = (D / 64) * (D / 32), I_PW = (256 / 64) * (256 / 32), I_PL = 2;
        constexpr int NITEMS = DEPTH * (I_IN + I_OUT + I_PW + 4 * I_PL);
        for (int it = gw; it < NITEMS; it += NGW) {
            int r = it;
            if (r < DEPTH * I_IN) { const int l = r / I_IN; p0_transpose_item(w_in + (size_t)l * D * DIN, D, DIN, WIN + (size_t)l * DIN * D, scr, r % I_IN, lane, ln_g + l * D); continue; } r -= DEPTH * I_IN;
            if (r < DEPTH * I_OUT) { const int l = r / I_OUT; p0_transpose_item(w_out + (size_t)l * D * D, D, D, WOUT + (size_t)l * D * D, scr, r % I_OUT, lane, nullptr); continue; } r -= DEPTH * I_OUT;
            if (r < DEPTH * I_PW) { const int l = r / I_PW; p0_transpose_item(conv_pw + (size_t)l * 65536, 256, 256, WPW + (size_t)l * 65536, scr, r % I_PW, lane, nullptr); continue; } r -= DEPTH * I_PW;
            { const int lg = r / I_PL; p0_transpose_item(pool_w + (size_t)lg * 4096, 64, 64, WPOOL + (size_t)lg * 4096, scr, r % I_PL, lane, nullptr); }
        }
        for (int m0 = gw; m0 < M; m0 += 4 * NGW) {
            f32x4 v[4][4];
#pragma unroll
            for (int r = 0; r < 4; ++r) { const int m = m0 + r * NGW; if (m < M) { const GAS f32x4* xr = (const GAS f32x4*)(x + (size_t)m * D) + lane;
#pragma unroll
                for (int j = 0; j < 4; ++j) v[r][j] = xr[64 * j]; } }
#pragma unroll
            for (int r = 0; r < 4; ++r) { const int m = m0 + r * NGW; if (m < M) { float s = 0.f;
#pragma unroll
                for (int j = 0; j < 4; ++j) s += (v[r][j].x * v[r][j].x + v[r][j].y * v[r][j].y) + (v[r][j].z * v[r][j].z + v[r][j].w * v[r][j].w);
                s = wave_sum(s);
                GAS unsigned long long* o8 = (GAS unsigned long long*)(XB + (size_t)m * D) + lane;
#pragma unroll
                for (int j = 0; j < 4; ++j) o8[64 * j] = (unsigned long long)pk2(v[r][j].x, v[r][j].y) | ((unsigned long long)pk2(v[r][j].z, v[r][j].w) << 32);
                if (lane == 0) *(f32x4*)(SSP + (size_t)m * 4) = (f32x4){s, 0.f, 0.f, 0.f}; } }
        }
    }
    }
    SEAM(0);
    for (int i = 0; i < PROBE_XBAR; ++i) xcd_barrier(bar);
    for (int l = 0; l < DEPTH; ++l) {
        const int pb = 1 + 3 * l;
        for (int rep = 0; rep < REPS(pb); ++rep) { if (rep) xcd_barrier(bar);
        if (IN(pb)) {
            pg8::Gemm g{XB, WIN + (size_t)l * DIN * D, M, DIN, D}; pg8::StaticOrder S; S.init(M, DIN, G, (int)blockIdx.x);
            pg8::EpiProj E{PROJ, DIN, SSP + (size_t)l * M * 4};
            pg8::gemm_phase<pg8::EpiProj, pg8::StaticOrder, true, true>(L + RING_OFF, g, S, E);
        }
        }
        SEAM(pb);
        for (int rep = 0; rep < REPS(pb + 1); ++rep) { if (rep) xcd_barrier(bar);
        if (IN(pb + 1)) {
            int tid = threadIdx.x; asm volatile("" : "+v"(tid));
            const int lane = tid & 63;
            MixW W{pool_scale + l * 256, conv_dw + l * 31 * 256, conv_b + l * 256, conv_ln_g + l * 256, conv_ln_b + l * 256, attn_sinks + l * 8, WPW + (size_t)l * 65536, WPOOL + (size_t)l * 16384};
            for (int u = blockIdx.x; u < 256; u += G) attn_unit(L, PROJ, Y, W, u, tid, lane, wave);
            for (int u = blockIdx.x; u < 512; u += G) conv_unit(L, PROJ, Y, W, 32 * u, tid, lane, wave);
            for (int u = blockIdx.x; u < 512; u += G) pool_unit(L, PROJ, Y, W, 32 * u, tid, lane, wave);
        }
        }
        SEAM(pb + 1);
        if (IN(pb + 2)) {
            pg8::Gemm g{Y, WOUT + (size_t)l * D * D, M, D, D}; pg8::StaticOrder S; S.init(M, D, G, (int)blockIdx.x);
            pg8::EpiRes E{x, XB, SSP + (size_t)(l + 1) * M * 4, D, l};
            pg8::gemm_phase<pg8::EpiRes, pg8::StaticOrder, false, true>(L + RING_OFF, g, S, E);
        }
        SEAM(pb + 2);
    }
    if (IN(7)) {
        int tid = threadIdx.x; asm volatile("" : "+v"(tid));
        const int lane = tid & 63;
        const int gw = blockIdx.x * NWAVES + wave, NGW = G * NWAVES;
        const float* ssp2 = SSP + (size_t)2 * M * 4;
        f32x4 gg[4];
#pragma unroll
        for (int h = 0; h < 2; ++h) { gg[2 * h] = *(const GAS f32x4*)(final_g + 512 * h + 8 * lane); gg[2 * h + 1] = *(const GAS f32x4*)(final_g + 512 * h + 8 * lane + 4); }
        for (int m0 = gw; m0 < M; m0 += 4 * NGW) {
            v4u xv[4][2]; f32x4 sp[4];
#pragma unroll
            for (int r = 0; r < 4; ++r) { const int m = m0 + r * NGW; if (m < M) { xv[r][0] = *(const GAS v4u*)(XB + (size_t)m * D + 8 * lane); xv[r][1] = *(const GAS v4u*)(XB + (size_t)m * D + 512 + 8 * lane); sp[r] = *(const GAS f32x4*)(ssp2 + (size_t)m * 4); } }
#pragma unroll
            for (int r = 0; r < 4; ++r) { const int m = m0 + r * NGW; if (m < M) {
                const float rs = rsqrtf(((sp[r][0] + sp[r][1]) + (sp[r][2] + sp[r][3])) * (1.f / D) + EPS);
#pragma unroll
                for (int h = 0; h < 2; ++h) { const v4u w = xv[r][h];
                    const f32x4 a = (f32x4){bflo(w.x), bfhi(w.x), bflo(w.y), bfhi(w.y)} * rs * gg[2 * h], b = (f32x4){bflo(w.z), bfhi(w.z), bflo(w.w), bfhi(w.w)} * rs * gg[2 * h + 1];
                    GAS f32x4* o = (GAS f32x4*)(out + (size_t)m * D + 512 * h + 8 * lane); o[0] = a; o[1] = b; } } }
        }
    }
#undef IN
#undef SEAM
}

extern "C" void kernel_launch(void* const* d_in, const int* in_sizes, int n_in, void* d_out, int out_size, void* d_ws, size_t ws_size, hipStream_t stream) {
    static int grid = 0;
    if (grid == 0) {
        if (n_in != 13 || in_sizes[0] != M * D || out_size != M * D || ws_size < WS_END) { fprintf(stderr, "kernel_launch: unexpected shapes (n_in %d in0 %d out %d ws %zu)\n", n_in, n_in > 0 ? in_sizes[0] : -1, out_size, ws_size); grid = -1; return; }
        int dev = 0, cus = 0, per_cu = 0;
        if (hipGetDevice(&dev) != hipSuccess || hipDeviceGetAttribute(&cus, hipDeviceAttributeMultiprocessorCount, dev) != hipSuccess) { grid = -1; return; }
        if (hipFuncSetAttribute((const void*)fwd, hipFuncAttributeMaxDynamicSharedMemorySize, LDS_BYTES) != hipSuccess) { fprintf(stderr, "kernel_launch: hipFuncSetAttribute failed\n"); grid = -1; return; }
        if (hipOccupancyMaxActiveBlocksPerMultiprocessor(&per_cu, (const void*)fwd, NWAVES * 64, LDS_BYTES) != hipSuccess || per_cu < 1) { fprintf(stderr, "kernel_launch: occupancy query says %d blocks/CU\n", per_cu); }
        (void)hipGetLastError();
        if (cus != 256) { fprintf(stderr, "kernel_launch: built for a 256-CU device, found %d\n", cus); grid = -1; return; }
        grid = cus;
    }
    if (grid < 0) return;
    if (hipMemsetAsync((char*)d_ws + WS_CTL, 0, CTL_ZERO_BYTES, stream) != hipSuccess) return;
    Args a{};
    for (int i = 0; i < 13; ++i) a.in[i] = (const float*)d_in[i];
    a.out = (float*)d_out; a.ws = (unsigned char*)d_ws;
    for (int li = 0; li < N_LAUNCHES; ++li) {
        a.ph_lo = (N_LAUNCHES == 1) ? 0 : li; a.ph_hi = (N_LAUNCHES == 1) ? NPH : li + 1;
        hipLaunchKernelGGL(fwd, dim3(grid), dim3(NWAVES * 64), LDS_BYTES, stream, a);
    }
}
```

```cpp
#include <hip/hip_runtime.h>
#include <cstdio>
#include <cstdint>
namespace pg8 {
#define PG8_LAS __attribute__((address_space(3)))
typedef unsigned short bf16_t;
typedef short bf16x8 __attribute__((ext_vector_type(8)));
typedef float f32x4 __attribute__((ext_vector_type(4)));
typedef unsigned u32x4 __attribute__((ext_vector_type(4)));
constexpr int BM = 256, BK = 64, HALF = 128, HTB = HALF * BK * 2  , STAGE_BYTES = 8 * HTB, NXCD = 8, WGM = 8;

__host__ __device__ __forceinline__ int lds_byte(int r, int c) { const int st = (r >> 4) * 2 + (c >> 5), rr = r & 15, cc = c & 31, ob = rr * 64 + cc * 2; return st * 1024 + (ob ^ (((ob >> 9) & 1) << 5)); }
__host__ __device__ __forceinline__ void stage_rc(int b, int& R, int& C) { const int st = b / 1024, sb = b % 1024, swz = sb ^ (((sb >> 9) & 1) << 5); R = (st >> 1) * 16 + swz / 64; C = (st & 1) * 32 + (swz % 64) / 2; }
__host__ __device__ __forceinline__ int perm32(int rho) { const int n = rho >> 4, i = rho & 15; return 8 * (i >> 2) + 4 * n + (i & 3); }

struct Unit { int pm, pn; };
struct Gemm { const bf16_t* A; const bf16_t* Bt; int M, N, K; };

struct StaticOrder {
    int nM, nN, nwg, G, c;
    __host__ __device__ void init(int M, int N, int G_, int c_) { nM = M / BM; nN = N / BM; nwg = nM * nN; G = G_; c = c_; }
    __host__ __device__ bool next(int i, Unit& u) const {
        const long L = (long)i * G + c; if (L >= nwg) return false;
        int wgid = (int)L; { const int q = nwg / NXCD, r = nwg % NXCD, xcd = wgid % NXCD, off = wgid / NXCD; wgid = (xcd < r ? xcd * (q + 1) : r * (q + 1) + (xcd - r) * q) + off; }
        const int nig = WGM * nN, gid = wgid / nig, fm = gid * WGM, gsz = (nM - fm) < WGM ? (nM - fm) : WGM;
        u.pm = fm + ((wgid % nig) % gsz); u.pn = (wgid % nig) / gsz; return true;
    }
    __device__ __forceinline__ void a_ready(const Unit&) const {}
    __device__ __forceinline__ void done(const Unit&) const {}
};

__device__ __forceinline__ unsigned cvt_pk_bf16(float lo, float hi) { unsigned r; asm volatile("v_cvt_pk_bf16_f32 %0, %1, %2" : "=v"(r) : "v"(lo), "v"(hi)); return r; }
typedef float f32x2 __attribute__((ext_vector_type(2)));
typedef unsigned u32x2 __attribute__((ext_vector_type(2)));
struct EpiProj {
    static constexpr bool PERM = true, AFTER_DRAIN = false;
    bf16_t* O; int ldc; const float* ssp;
    __device__ __forceinline__ void operator()(const f32x4 (&acc)[2][2][4][2], const Unit& u, int wr, int wc, int fr, int fq) const {
        const int row0 = u.pm * BM + wr * 64 + fr, col0 = u.pn * BM + wc * 32 + 8 * fq;
        const float qs = (u.pn == 5 || u.pn == 6) ? 0.18033688011112042f : 1.0f;
#pragma unroll
        for (int ai = 0; ai < 2; ++ai)
#pragma unroll
            for (int m = 0; m < 4; ++m) {
                const int row = row0 + ai * HALF + m * 16;
                const f32x4 s = *(const f32x4*)(ssp + (size_t)row * 4);
                const float rs = qs * rsqrtf(((s[0] + s[1]) + (s[2] + s[3])) * (1.0f / 1024.0f) + 1e-6f);
                bf16_t* rowp = O + (size_t)row * ldc + col0;
#pragma unroll
                for (int bj = 0; bj < 2; ++bj) { const f32x4 v0 = acc[ai][bj][m][0] * rs, v1 = acc[ai][bj][m][1] * rs;
                    u32x4 w; w.x = cvt_pk_bf16(v0[0], v0[1]); w.y = cvt_pk_bf16(v0[2], v0[3]); w.z = cvt_pk_bf16(v1[0], v1[1]); w.w = cvt_pk_bf16(v1[2], v1[3]);
                    *(u32x4*)(rowp + bj * HALF) = w; }
            }
    }
};
struct EpiRes {
    static constexpr bool PERM = false, AFTER_DRAIN = true;
    const float* basef; bf16_t* xb; float* ssp; int ldc; int base_bf16;
    __device__ __forceinline__ void fused(f32x4 (&acc)[2][2][4][2], const Unit& u, int wr, int wc, int fr, int fq, PG8_LAS unsigned char* lds, int wid, int lane) const {
        PG8_LAS float* P = (PG8_LAS float*)lds;
        const int col0 = u.pn * BM + wc * 32 + 4 * fq;
#pragma unroll
        for (int ai = 0; ai < 2; ++ai)
#pragma unroll
            for (int m = 0; m < 4; ++m) { const int r = ai * HALF + wr * 64 + m * 16 + fr; const size_t off = (size_t)(u.pm * BM + r) * ldc + col0; float s = 0.f;
                f32x4 bs[2][2];
                if (base_bf16) {
#pragma unroll
                    for (int bj = 0; bj < 2; ++bj)
#pragma unroll
                        for (int n = 0; n < 2; ++n) { const u32x2 w = *(const u32x2*)(xb + off + bj * HALF + n * 16);
                            bs[bj][n] = (f32x4){__uint_as_float(w.x << 16), __uint_as_float(w.x & 0xffff0000u), __uint_as_float(w.y << 16), __uint_as_float(w.y & 0xffff0000u)}; }
                } else {
#pragma unroll
                    for (int bj = 0; bj < 2; ++bj)
#pragma unroll
                        for (int n = 0; n < 2; ++n) bs[bj][n] = *(const f32x4*)(basef + off + bj * HALF + n * 16);
                }
#pragma unroll
                for (int bj = 0; bj < 2; ++bj)
#pragma unroll
                    for (int n = 0; n < 2; ++n) { const f32x4 o = bs[bj][n] + acc[ai][bj][m][n];
                        u32x2 w; w.x = cvt_pk_bf16(o[0], o[1]); w.y = cvt_pk_bf16(o[2], o[3]); *(u32x2*)(xb + off + bj * HALF + n * 16) = w;
                        s += (o[0] * o[0] + o[1] * o[1]) + (o[2] * o[2] + o[3] * o[3]); }
                s += __shfl_xor(s, 16); s += __shfl_xor(s, 32);
                if (fq == 0) P[r * 4 + wc] = s;
                if (m & 1) asm volatile("" ::: "memory"); }
        asm volatile("s_waitcnt lgkmcnt(0)" ::: "memory"); __builtin_amdgcn_s_barrier(); asm volatile("" ::: "memory");
        const int tid = wid * 64 + lane;
        if (tid < 256) { const f32x4 p = *(const PG8_LAS f32x4*)(P + tid * 4); ssp[(size_t)(u.pm * BM + tid) * 4 + u.pn] = (p[0] + p[1]) + (p[2] + p[3]); }
        asm volatile("s_waitcnt lgkmcnt(0)" ::: "memory"); __builtin_amdgcn_s_barrier(); asm volatile("" ::: "memory");
    }
};
template <class Epi, class Sched, bool ALIGN_EPI = false, bool SP2 = false>
__device__ __forceinline__ void gemm_phase(PG8_LAS unsigned char* lds, const Gemm g, const Sched& S, const Epi& E) {
    int tid_ = threadIdx.x; asm volatile("" : "+v"(tid_));
    const int tid = tid_, wid = __builtin_amdgcn_readfirstlane(tid >> 6), lane = tid & 63, wr = wid >> 2, wc = wid & 3, fr = lane & 15, fq = lane >> 4;
    const int K = g.K, nt = K / BK;
    unsigned voffA[2], voffB[2];
#pragma unroll
    for (int i = 0; i < 2; ++i) { int R, C; stage_rc(tid * 16 + i * 8192, R, C); const int Rb = Epi::PERM ? ((R & ~31) + perm32(R & 31)) : R;
        voffA[i] = (unsigned)(R * K + C) * 2u; voffB[i] = (unsigned)(Rb * K + C) * 2u; }
    const size_t kstep = (size_t)(BK * 2);
    const size_t hstep = (size_t)HALF * K * 2;
    const size_t tstep = 2 * hstep;
    const unsigned ldsw = (unsigned)wid * 1024u;
    const int aoff = lds_byte(wr * 64 + fr, fq * 8), boff = lds_byte(wc * 32 + fr, fq * 8);
#define PG8_SA(b, h) (((b) * 2 + (h)) * HTB)
#define PG8_SB(b, h) ((4 + (b) * 2 + (h)) * HTB)
#define PG8_STAGE(bufoff, gbase, voff) do { _Pragma("unroll") for (int _i = 0; _i < 2; ++_i) \
        __builtin_amdgcn_global_load_lds((const unsigned*)((const char*)(gbase) + (voff)[_i]), (PG8_LAS unsigned*)(lds + (bufoff) + ldsw + _i * 8192), 16, 0, 0); } while (0)
#define PG8_LDA(dst, b, h) do { _Pragma("unroll") for (int m = 0; m < 4; ++m) _Pragma("unroll") for (int k = 0; k < 2; ++k) dst[m][k] = *(const PG8_LAS bf16x8*)(lds + PG8_SA(b, h) + aoff + m * 2048 + k * 1024); } while (0)
#define PG8_LDB(dst, b, h) do { _Pragma("unroll") for (int n = 0; n < 2; ++n) _Pragma("unroll") for (int k = 0; k < 2; ++k) dst[n][k] = *(const PG8_LAS bf16x8*)(lds + PG8_SB(b, h) + boff + n * 2048 + k * 1024); } while (0)
#define PG8_MMA(ai, bj, At, Bt) do { __builtin_amdgcn_s_setprio(1); _Pragma("unroll") for (int m = 0; m < 4; ++m) _Pragma("unroll") for (int n = 0; n < 2; ++n) _Pragma("unroll") for (int k = 0; k < 2; ++k) \
        acc[ai][bj][m][n] = __builtin_amdgcn_mfma_f32_16x16x32_bf16(Bt[n][k], At[m][k], acc[ai][bj][m][n], 0, 0, 0); __builtin_amdgcn_s_setprio(0); } while (0)
#define PG8_WAIT_V(n) asm volatile("s_waitcnt vmcnt(" #n ")" ::: "memory")
#define PG8_WAIT_L(n) asm volatile("s_waitcnt lgkmcnt(" #n ")" ::: "memory")
#define PG8_BAR __builtin_amdgcn_s_barrier()
#define PG8_SCHED __builtin_amdgcn_sched_barrier(0)
    Unit cur, nxt; int ui = 0;
    if (!S.next(0, cur)) return;
    f32x4 acc[2][2][4][2];
#pragma unroll
    for (int a = 0; a < 2; ++a)
#pragma unroll
        for (int b = 0; b < 2; ++b)
#pragma unroll
            for (int m = 0; m < 4; ++m)
#pragma unroll
                for (int n = 0; n < 2; ++n) acc[a][b][m][n] = (f32x4){0.f, 0.f, 0.f, 0.f};
    bf16x8 At[4][2], B0[2][2], B1[2][2];
    const char* cA = (const char*)g.A + (size_t)cur.pm * tstep; const char* cB = (const char*)g.Bt + (size_t)cur.pn * tstep;
    S.a_ready(cur);
    if constexpr (SP2) {
        PG8_STAGE(PG8_SB(0, 0), cB, voffB); PG8_STAGE(PG8_SB(0, 1), cB + hstep, voffB); PG8_STAGE(PG8_SA(0, 0), cA, voffA); PG8_STAGE(PG8_SA(0, 1), cA + hstep, voffA);
        if (wr == 1) PG8_BAR;
        PG8_WAIT_V(2); PG8_BAR;
        PG8_STAGE(PG8_SB(1, 0), cB + kstep, voffB); PG8_STAGE(PG8_SA(1, 0), cA + kstep, voffA); PG8_STAGE(PG8_SB(1, 1), cB + hstep + kstep, voffB);
        PG8_WAIT_V(6); PG8_BAR;
    } else {
        PG8_STAGE(PG8_SB(0, 0), cB, voffB); PG8_STAGE(PG8_SA(0, 0), cA, voffA); PG8_STAGE(PG8_SB(0, 1), cB + hstep, voffB); PG8_STAGE(PG8_SA(0, 1), cA + hstep, voffA);
        if (wr == 1) PG8_BAR;
        PG8_WAIT_V(4); PG8_BAR;
        PG8_STAGE(PG8_SB(1, 0), cB + kstep, voffB); PG8_STAGE(PG8_SA(1, 0), cA + kstep, voffA); PG8_STAGE(PG8_SB(1, 1), cB + hstep + kstep, voffB);
        PG8_WAIT_V(6); PG8_BAR;
    }
    for (;;) {
        const bool has_next = S.next(ui + 1, nxt);
        const char* nA = has_next ? (const char*)g.A + (size_t)nxt.pm * tstep : cA; const char* nB = has_next ? (const char*)g.Bt + (size_t)nxt.pn * tstep : cB;
        for (int t = 0; t < nt; t += 2) {
            const bool last = (t == nt - 2);
            const char* a1 = cA + (size_t)(t + 1) * kstep;
            const char* a2 = last ? nA : cA + (size_t)(t + 2) * kstep; const char* b2 = last ? nB : cB + (size_t)(t + 2) * kstep;
            const char* a3 = a2 + kstep; const char* b3 = b2 + kstep;
            if (last && has_next) S.a_ready(nxt);
            if constexpr (SP2) {
            PG8_LDB(B0, 0, 0); PG8_LDB(B1, 0, 1); PG8_SCHED; PG8_LDA(At, 0, 0); PG8_STAGE(PG8_SA(1, 1), a1 + hstep, voffA);
            PG8_WAIT_V(8); PG8_WAIT_L(0); PG8_BAR; PG8_MMA(0, 0, At, B0); PG8_MMA(0, 1, At, B1); PG8_BAR; PG8_SCHED;
            PG8_LDA(At, 0, 1); PG8_STAGE(PG8_SB(0, 0), b2, voffB); PG8_STAGE(PG8_SB(0, 1), b2 + hstep, voffB); PG8_STAGE(PG8_SA(0, 0), a2, voffA);
            PG8_WAIT_V(8); PG8_WAIT_L(0); PG8_BAR; PG8_MMA(1, 0, At, B0); PG8_MMA(1, 1, At, B1); PG8_BAR; PG8_SCHED;
            PG8_LDB(B0, 1, 0); PG8_LDB(B1, 1, 1); PG8_SCHED; PG8_LDA(At, 1, 0); PG8_STAGE(PG8_SA(0, 1), a2 + hstep, voffA);
            PG8_WAIT_V(8); PG8_WAIT_L(0); PG8_BAR; PG8_MMA(0, 0, At, B0); PG8_MMA(0, 1, At, B1); PG8_BAR; PG8_SCHED;
            PG8_LDA(At, 1, 1); PG8_STAGE(PG8_SB(1, 0), b3, voffB); PG8_STAGE(PG8_SB(1, 1), b3 + hstep, voffB); PG8_STAGE(PG8_SA(1, 0), a3, voffA);
            PG8_WAIT_V(8); PG8_WAIT_L(0); PG8_BAR; PG8_MMA(1, 0, At, B0); PG8_MMA(1, 1, At, B1); PG8_BAR; PG8_SCHED;
            } else {
            PG8_LDB(B0, 0, 0); PG8_SCHED; PG8_LDA(At, 0, 0); PG8_STAGE(PG8_SA(1, 1), a1 + hstep, voffA);
            PG8_WAIT_L(8); PG8_BAR; PG8_WAIT_L(0); PG8_MMA(0, 0, At, B0); PG8_BAR; PG8_SCHED;
            PG8_LDB(B1, 0, 1); PG8_STAGE(PG8_SB(0, 0), b2, voffB);
            PG8_BAR; PG8_WAIT_L(0); PG8_MMA(0, 1, At, B1); PG8_BAR;
            PG8_LDA(At, 0, 1); PG8_STAGE(PG8_SA(0, 0), a2, voffA);
            PG8_BAR; PG8_WAIT_L(0); PG8_MMA(1, 0, At, B0); PG8_BAR; PG8_SCHED;
            PG8_STAGE(PG8_SB(0, 1), b2 + hstep, voffB);
            PG8_WAIT_V(6); PG8_BAR; PG8_MMA(1, 1, At, B1); PG8_BAR;
            PG8_LDB(B0, 1, 0); PG8_SCHED; PG8_LDA(At, 1, 0); PG8_STAGE(PG8_SA(0, 1), a2 + hstep, voffA);
            PG8_WAIT_L(8); PG8_BAR; PG8_WAIT_L(0); PG8_MMA(0, 0, At, B0); PG8_BAR; PG8_SCHED;
            PG8_LDB(B1, 1, 1); PG8_STAGE(PG8_SB(1, 0), b3, voffB);
            PG8_BAR; PG8_WAIT_L(0); PG8_MMA(0, 1, At, B1); PG8_BAR;
            PG8_LDA(At, 1, 1); PG8_STAGE(PG8_SA(1, 0), a3, voffA);
            PG8_BAR; PG8_WAIT_L(0); PG8_MMA(1, 0, At, B0); PG8_BAR; PG8_SCHED;
            PG8_STAGE(PG8_SB(1, 1), b3 + hstep, voffB);
            PG8_WAIT_V(6); PG8_BAR; PG8_MMA(1, 1, At, B1); PG8_BAR;
            }
        }
        if constexpr (ALIGN_EPI) { if (wr == 0) PG8_BAR; }
        if constexpr (!Epi::AFTER_DRAIN) { E(acc, cur, wr, wc, fr, fq); S.done(cur); }
        if (!has_next) break;
#pragma unroll
        for (int a = 0; a < 2; ++a)
#pragma unroll
            for (int b = 0; b < 2; ++b)
#pragma unroll
                for (int m = 0; m < 4; ++m)
#pragma unroll
                    for (int n = 0; n < 2; ++n) acc[a][b][m][n] = (f32x4){0.f, 0.f, 0.f, 0.f};
        cur = nxt; cA = nA; cB = nB; ++ui;
        if constexpr (ALIGN_EPI) { if (wr == 1) PG8_BAR; }
    }
    PG8_WAIT_V(0);
    if constexpr (!ALIGN_EPI) { if (wr == 0) PG8_BAR; }
    PG8_BAR;
    if constexpr (Epi::AFTER_DRAIN) { E.fused(acc, cur, wr, wc, fr, fq, lds, wid, lane); S.done(cur); }
#undef PG8_SA
#undef PG8_SB
#undef PG8_STAGE
#undef PG8_LDA
#undef PG8_LDB
#undef PG8_MMA
#undef PG8_WAIT_V
#undef PG8_WAIT_L
#undef PG8_BAR
#undef PG8_SCHED
}
}
constexpr int NWAVES = 8;
#ifndef MK_N_LAUNCHES
#define MK_N_LAUNCHES 1
#endif
#ifndef PROBE_DUP
#define PROBE_DUP -1
#endif
#ifndef PROBE_XBAR
#define PROBE_XBAR 0
#endif
constexpr int N_LAUNCHES = MK_N_LAUNCHES;
constexpr int NPH = 8;
constexpr int D = 1024, BATCH = 2, SEQ = 8192, M = BATCH * SEQ, DIN = 2560, DEPTH = 2;
constexpr int C_UPOOL = 0, C_GPOOL = 256, C_CA = 512, C_CB = 768, C_GCONV = 1024, C_Q = 1280, C_K = 1792, C_V = 1920, C_GATTN = 2048;
constexpr float EPS = 1e-6f;
constexpr size_t MiB = 1u << 20;
constexpr size_t WS_CTL = 0, CTL_ZERO_BYTES = 1 * MiB;
constexpr size_t WS_WIN = 2 * MiB;
constexpr size_t WS_WOUT = 12 * MiB;
constexpr size_t WS_WPW = 16 * MiB;
constexpr size_t WS_WPOOL = 16 * MiB + 512 * 1024;
constexpr size_t WS_SSP = 17 * MiB;
constexpr size_t WS_XB = 32 * MiB;
constexpr size_t WS_PROJ = 64 * MiB;
constexpr size_t WS_Y = 144 * MiB;
constexpr size_t WS_END = 176 * MiB;
constexpr int CW_BAR = 4096;
constexpr int RING_OFF = 0, RING_BYTES = 131072, LDSCTL_OFF = 146432, MISC_OFF = LDSCTL_OFF + 320, LDS_BYTES = 147456;
#define GAS __attribute__((address_space(1)))
#define LAS __attribute__((address_space(3)))
typedef unsigned short bf16;
typedef unsigned v4u __attribute__((ext_vector_type(4)));
typedef float f32x4 __attribute__((ext_vector_type(4)));
typedef short bf16x8 __attribute__((ext_vector_type(8)));
typedef GAS unsigned gu32;
typedef GAS unsigned long long gu64;
#define RLX_AGENT __ATOMIC_RELAXED, __HIP_MEMORY_SCOPE_AGENT
#define LDS_WAIT() asm volatile("s_waitcnt lgkmcnt(0)" ::: "memory")
#define VM_WAIT() asm volatile("s_waitcnt vmcnt(0)" ::: "memory")
__device__ __forceinline__ unsigned long long rt() { return __builtin_amdgcn_s_memrealtime(); }
__device__ __forceinline__ unsigned f2bf(float f) { unsigned u = __builtin_bit_cast(unsigned, f); return (u + 0x7fffu + ((u >> 16) & 1u)) >> 16; }
__device__ __forceinline__ unsigned pk2(float lo, float hi) { return f2bf(lo) | (f2bf(hi) << 16); }
#define XB_TMO      128
#define XB_XCNT(j)  (256  + 64 * (j))
#define XB_XSUB(j)  (1280 + 64 * (j))
#define XB_XGEN(j)  (2304 + 64 * (j))
#define XB_TOP      3328
#define XB_TOPGEN   3392
#define XCD_BAR_WORDS 3456
#define XB_SPIN_CAP (1u << 18)

__device__ __forceinline__ unsigned xb_ld(unsigned* p)              { return __hip_atomic_load(p, __ATOMIC_RELAXED, __HIP_MEMORY_SCOPE_AGENT); }
__device__ __forceinline__ unsigned xb_add(unsigned* p, unsigned v) { return __hip_atomic_fetch_add(p, v, __ATOMIC_RELAXED, __HIP_MEMORY_SCOPE_AGENT); }
__device__ __forceinline__ unsigned xb_xcc_id() { return (unsigned)__builtin_amdgcn_s_getreg((3 << 11) | 20) & 0xFu; }
#define XB_SPIN(cond, bar) do { unsigned _sp = 0; while (cond) { __builtin_amdgcn_s_sleep(1); \
    if ((++_sp & 255u) == 0u) { if (xb_ld(&(bar)[XB_TMO])) break; if (_sp > XB_SPIN_CAP) { atomicAdd(&(bar)[XB_TMO], 1u); break; } } } } while (0)

struct XcdBarrier {
    unsigned* bar; unsigned x;
    volatile LAS unsigned* st;
};

__device__ __forceinline__ XcdBarrier xcd_barrier_post(unsigned* bar, volatile LAS unsigned* st) {
    XcdBarrier b; b.bar = bar; b.x = xb_xcc_id(); b.st = st;
    if (threadIdx.x == 0) (void)xb_add(&bar[XB_XCNT(b.x)], 1u);
    return b;
}
__device__ __forceinline__ void xcd_barrier_complete(unsigned* bar, unsigned x, unsigned& nloc, unsigned& nx) {
    const unsigned G = gridDim.x * gridDim.y * gridDim.z;
    unsigned sum, cnt, mine, sp = 0u;
    for (;;) {
        sum = 0u; cnt = 0u; mine = 0u;
#pragma unroll
        for (unsigned j = 0; j < 16; ++j) { const unsigned c = xb_ld(&bar[XB_XCNT(j)]); sum += c; cnt += (c > 0u) ? 1u : 0u; mine = (j == x) ? c : mine; }
        if (sum == G) break;
        __builtin_amdgcn_s_sleep(1);
        if ((++sp & 255u) == 0u) { if (xb_ld(&bar[XB_TMO])) break; if (sp > XB_SPIN_CAP) { atomicAdd(&bar[XB_TMO], 1u); break; } }
    }
    nloc = mine > 0u ? mine : 1u; nx = cnt > 0u ? cnt : 1u;
}

__device__ __forceinline__ void xcd_barrier(const XcdBarrier& b) {
    asm volatile("s_waitcnt vmcnt(0)" ::: "memory");
    __syncthreads();
    if (threadIdx.x == 0) {
        unsigned* bar = b.bar;
        __builtin_amdgcn_s_waitcnt(0);
        unsigned nloc = b.st[0], nx = b.st[1];
        if (nloc == 0u) { xcd_barrier_complete(bar, b.x, nloc, nx); b.st[0] = nloc; b.st[1] = nx; }
        const unsigned old = xb_add(&bar[XB_XSUB(b.x)], 1u);
        const unsigned gen = old / nloc;
        if (old + 1u == (gen + 1u) * nloc) {
            __builtin_amdgcn_fence(__ATOMIC_RELEASE, "agent");
            asm volatile("s_waitcnt vmcnt(0)" ::: "memory");
            const unsigned og = xb_add(&bar[XB_TOP], 1u);
            const unsigned tg = og / nx;
            if (og + 1u == (tg + 1u) * nx) xb_add(&bar[XB_TOPGEN], 1u);
            else XB_SPIN(xb_ld(&bar[XB_TOPGEN]) == tg, bar);
            __builtin_amdgcn_fence(__ATOMIC_ACQUIRE, "agent");
            xb_add(&bar[XB_XGEN(b.x)], 1u);
            asm volatile("s_waitcnt vmcnt(0)" ::: "memory");
        } else {
            XB_SPIN(xb_ld(&bar[XB_XGEN(b.x)]) == gen, bar);
            __builtin_amdgcn_fence(__ATOMIC_ACQUIRE, "agent");
            asm volatile("s_waitcnt vmcnt(0)" ::: "memory");
        }
    }
    __syncthreads();
}
typedef float f32x16 __attribute__((ext_vector_type(16)));
typedef short s16x4 __attribute__((ext_vector_type(4)));
typedef float f32x2_t __attribute__((ext_vector_type(2)));
typedef __bf16 bf16x2_t __attribute__((ext_vector_type(2)));
#define MFMA32(a, b, c) __builtin_amdgcn_mfma_f32_32x32x16_bf16((a), (b), (c), 0, 0, 0)
__device__ __forceinline__ int crow(int r, int hi) { return (r & 3) + 8 * (r >> 2) + 4 * hi; }
__device__ __forceinline__ unsigned cvtpk(float lo, float hi) { f32x2_t v = {lo, hi}; bf16x2_t b = __builtin_convertvector(v, bf16x2_t); return __builtin_bit_cast(unsigned, b); }
__device__ __forceinline__ float bflo(unsigned w) { return __uint_as_float(w << 16); }
__device__ __forceinline__ float bfhi(unsigned w) { return __uint_as_float(w & 0xffff0000u); }
__device__ __forceinline__ float fsilu(float x) { return x * __builtin_amdgcn_rcpf(1.f + __builtin_amdgcn_exp2f(-1.4426950408889634f * x)); }
__device__ __forceinline__ float fsigm(float x) { return __builtin_amdgcn_rcpf(1.f + __builtin_amdgcn_exp2f(-1.4426950408889634f * x)); }
__device__ __forceinline__ bf16x8 packP(const f32x16& p, int s) {
    v4u w; w.x = cvtpk(p[8 * s], p[8 * s + 1]); w.y = cvtpk(p[8 * s + 2], p[8 * s + 3]); w.z = cvtpk(p[8 * s + 4], p[8 * s + 5]); w.w = cvtpk(p[8 * s + 6], p[8 * s + 7]);
    return __builtin_bit_cast(bf16x8, w);
}
constexpr int STG_LD = 36;
constexpr int BL_STG = 0, BL_INVL = 8 * 32 * STG_LD * 4, BL_R1 = BL_INVL + 1024;
constexpr int AST = 528;
constexpr int CV_GLU = BL_R1, CV_HN = BL_R1, CV_OUT = BL_R1 + 62 * 1024;
constexpr int PL_U = BL_R1, PL_DIFF = BL_R1 + 47 * 1024;
constexpr int AT_K = BL_R1, AT_V = BL_R1 + 32768;
static_assert(CV_OUT + 32768 <= 146432 && PL_DIFF + 32 * AST <= 146432 && AT_V + 32768 <= 146432, "mixer LDS map");

__device__ __forceinline__ void gate_load(v4u (&gq)[2], const bf16* gate, int lane) {
#pragma unroll
    for (int it = 0; it < 2; ++it) { const int idx = it * 64 + lane, row = idx >> 2, c8 = (idx & 3) * 8; gq[it] = *(const GAS v4u*)(gate + (size_t)row * DIN + c8); }
}
__device__ __forceinline__ void tile_out(const f32x16& acc, float colscale, LAS float* stg, const LAS float* rowscale, const v4u (&gq)[2], bf16* yp, int lane) {
    const int r32 = lane & 31, hi = lane >> 5;
#pragma unroll
    for (int reg = 0; reg < 16; ++reg) stg[crow(reg, hi) * STG_LD + r32] = acc[reg] * colscale;
#pragma unroll
    for (int it = 0; it < 2; ++it) {
        const int idx = it * 64 + lane, row = idx >> 2, c8 = (idx & 3) * 8;
        f32x4 v0 = *(const LAS f32x4*)(stg + row * STG_LD + c8), v1 = *(const LAS f32x4*)(stg + row * STG_LD + c8 + 4);
        if (rowscale) { const float rs = rowscale[row]; v0 = v0 * rs; v1 = v1 * rs; }
        v4u o;
        o.x = cvtpk(v0[0] * fsilu(bflo(gq[it].x)), v0[1] * fsilu(bfhi(gq[it].x)));
        o.y = cvtpk(v0[2] * fsilu(bflo(gq[it].y)), v0[3] * fsilu(bfhi(gq[it].y)));
        o.z = cvtpk(v1[0] * fsilu(bflo(gq[it].z)), v1[1] * fsilu(bfhi(gq[it].z)));
        o.w = cvtpk(v1[2] * fsilu(bflo(gq[it].w)), v1[3] * fsilu(bfhi(gq[it].w)));
        *(GAS v4u*)(yp + (size_t)row * D + c8) = o;
    }
}

struct MixW { const float *pool_scale, *dw, *cb, *lg, *lb, *sinks; const bf16 *wpw, *wpool; };

__device__ __forceinline__ void conv_unit(LAS unsigned char* L, const bf16* PROJ, bf16* Y, const MixW& W, int tok0, int tid, int lane, int wave) {
    LAS float* GLU = (LAS float*)(L + CV_GLU); LAS float* CO = (LAS float*)(L + CV_OUT); LAS unsigned char* HN = L + CV_HN;
    const int t0 = tok0 & (SEQ - 1);
    v4u gq[2]; gate_load(gq, PROJ + (size_t)tok0 * DIN + C_GCONV + 32 * wave, lane);
    float w[31];
#pragma unroll
    for (int j = 0; j < 31; ++j) w[j] = W.dw[j * 256 + (tid & 255)];
    const float bias = W.cb[tid & 255];
    {
        v4u av[4], bv[4];
#pragma unroll
        for (int i = 0; i < 4; ++i) { const int e = tid + 512 * i, r = e >> 5, c8 = (e & 31) * 8;
            av[i] = (v4u){0u, 0u, 0u, 0u}; bv[i] = av[i];
            if (e < 62 * 32 && t0 - 30 + r >= 0) { const bf16* pr = PROJ + (size_t)(tok0 - 30 + r) * DIN; av[i] = *(const GAS v4u*)(pr + C_CA + c8); bv[i] = *(const GAS v4u*)(pr + C_CB + c8); } }
#pragma unroll
        for (int i = 0; i < 4; ++i) { const int e = tid + 512 * i, r = e >> 5, c8 = (e & 31) * 8;
            if (e < 62 * 32) { const v4u a = av[i], b = bv[i]; f32x4 g0, g1;
                g0[0] = bflo(a.x) * fsigm(bflo(b.x)); g0[1] = bfhi(a.x) * fsigm(bfhi(b.x)); g0[2] = bflo(a.y) * fsigm(bflo(b.y)); g0[3] = bfhi(a.y) * fsigm(bfhi(b.y));
                g1[0] = bflo(a.z) * fsigm(bflo(b.z)); g1[1] = bfhi(a.z) * fsigm(bfhi(b.z)); g1[2] = bflo(a.w) * fsigm(bflo(b.w)); g1[3] = bfhi(a.w) * fsigm(bfhi(b.w));
                *(LAS f32x4*)(GLU + r * 256 + c8) = g0; *(LAS f32x4*)(GLU + r * 256 + c8 + 4) = g1; } }
    }
    __syncthreads();
    const int tk = tid >> 4, part = tid & 15;
    f32x4 lgv[4], lbv[4];
#pragma unroll
    for (int i = 0; i < 4; ++i) { const int c = 64 * i + 4 * part; lgv[i] = *(const GAS f32x4*)(W.lg + c); lbv[i] = *(const GAS f32x4*)(W.lb + c); }
    {
        const int c = tid & 255, th = tid >> 8;
#pragma unroll
        for (int grp = 0; grp < 2; ++grp) {
            const int o0 = 16 * th + 8 * grp;
            float in[38];
#pragma unroll
            for (int k = 0; k < 38; ++k) in[k] = GLU[(o0 + k) * 256 + c];
#pragma unroll
            for (int o = 0; o < 8; ++o) { float a = bias;
#pragma unroll
                for (int j = 0; j < 31; ++j) a += w[j] * in[o + j];
                CO[(o0 + o) * 256 + c] = a; }
        }
    }
    __syncthreads();
    const int r32 = lane & 31, hi = lane >> 5;
    bf16x8 bfr[16];
    {
        const bf16* wrow = W.wpw + (size_t)(32 * wave + r32) * 256 + 8 * hi;
#pragma unroll
        for (int s = 0; s < 16; ++s) bfr[s] = *(const GAS bf16x8*)(wrow + 16 * s);
    }
    {
        f32x4 v[4]; float s = 0.f;
#pragma unroll
        for (int i = 0; i < 4; ++i) { v[i] = *(const LAS f32x4*)(CO + tk * 256 + 64 * i + 4 * part); s += (v[i][0] + v[i][1]) + (v[i][2] + v[i][3]); }
        s += __shfl_xor(s, 1); s += __shfl_xor(s, 2); s += __shfl_xor(s, 4); s += __shfl_xor(s, 8);
        const float mu = s * (1.f / 256.f); float q = 0.f;
#pragma unroll
        for (int i = 0; i < 4; ++i) { v[i] = v[i] - mu; q += (v[i][0] * v[i][0] + v[i][1] * v[i][1]) + (v[i][2] * v[i][2] + v[i][3] * v[i][3]); }
        q += __shfl_xor(q, 1); q += __shfl_xor(q, 2); q += __shfl_xor(q, 4); q += __shfl_xor(q, 8);
        const float rstd = rsqrtf(q * (1.f / 256.f) + EPS);
#pragma unroll
        for (int i = 0; i < 4; ++i) { const int c = 64 * i + 4 * part;
            const f32x4 y = v[i] * rstd * lgv[i] + lbv[i];
            pg8::u32x2 o; o.x = cvtpk(fsilu(y[0]), fsilu(y[1])); o.y = cvtpk(fsilu(y[2]), fsilu(y[3]));
            *(LAS pg8::u32x2*)(HN + tk * AST + c * 2) = o; }
    }
    __syncthreads();
    {
        f32x16 acc = {};
#pragma unroll
        for (int s = 0; s < 16; ++s) { const bf16x8 a = *(const LAS bf16x8*)(HN + r32 * AST + (16 * s + 8 * hi) * 2); acc = MFMA32(a, bfr[s], acc); }
        tile_out(acc, 1.f, (LAS float*)(L + BL_STG) + wave * 32 * STG_LD, nullptr, gq, Y + (size_t)tok0 * D + 256 + 32 * wave, lane);
    }
    __syncthreads();
}

__device__ __forceinline__ void pool_unit(LAS unsigned char* L, const bf16* PROJ, bf16* Y, const MixW& W, int tok0, int tid, int lane, int wave) {
    LAS float* U = (LAS float*)(L + PL_U); LAS unsigned char* DF = L + PL_DIFF;
    const int t0 = tok0 & (SEQ - 1);
    v4u gq[2]; gate_load(gq, PROJ + (size_t)tok0 * DIN + C_GPOOL + 32 * wave, lane);
    bf16x8 bfr[4];
    { const bf16* wrow = W.wpool + (size_t)(wave >> 1) * 4096 + (size_t)(32 * (wave & 1) + (lane & 31)) * 64 + 8 * (lane >> 5);
#pragma unroll
      for (int s = 0; s < 4; ++s) bfr[s] = *(const GAS bf16x8*)(wrow + 16 * s); }
    const float pscale = W.pool_scale[32 * wave + (lane & 31)];
    {
        v4u av[3];
#pragma unroll
        for (int i = 0; i < 3; ++i) { const int e = tid + 512 * i, r = e >> 5, c8 = (e & 31) * 8;
            av[i] = (v4u){0u, 0u, 0u, 0u};
            if (e < 47 * 32 && t0 - 15 + r >= 0) av[i] = *(const GAS v4u*)(PROJ + (size_t)(tok0 - 15 + r) * DIN + C_UPOOL + c8); }
#pragma unroll
        for (int i = 0; i < 3; ++i) { const int e = tid + 512 * i, r = e >> 5, c8 = (e & 31) * 8;
            if (e < 47 * 32) { const v4u a = av[i]; f32x4 g0, g1;
                g0[0] = bflo(a.x); g0[1] = bfhi(a.x); g0[2] = bflo(a.y); g0[3] = bfhi(a.y); g1[0] = bflo(a.z); g1[1] = bfhi(a.z); g1[2] = bflo(a.w); g1[3] = bfhi(a.w);
                *(LAS f32x4*)(U + r * 256 + c8) = g0; *(LAS f32x4*)(U + r * 256 + c8 + 4) = g1; } }
    }
    __syncthreads();
    {
        const int c = tid & 255, th = tid >> 8, g = wave & 3, wnd = 2 << g;
        const int R0 = 16 * th + 15;
        float s = 0.f;
        for (int k = 0; k < wnd; ++k) s += U[(R0 - k) * 256 + c];
#pragma unroll 4
        for (int o = 0; o < 16; ++o) {
            const int tp = t0 + 16 * th + o; const int cnt = (tp + 1 < wnd) ? tp + 1 : wnd;
            const float uv = U[(R0 + o) * 256 + c];
            const float df = s * __builtin_amdgcn_rcpf((float)cnt) - uv;
            *(LAS bf16*)(DF + (16 * th + o) * AST + c * 2) = (bf16)(cvtpk(df, 0.f) & 0xffffu);
            if (o < 15) s += U[(R0 + o + 1) * 256 + c] - U[(R0 + o + 1 - wnd) * 256 + c];
        }
    }
    __syncthreads();
    {
        const int r32 = lane & 31, hi = lane >> 5, g = wave >> 1;
        f32x16 acc = {};
#pragma unroll
        for (int s = 0; s < 4; ++s) { const bf16x8 a = *(const LAS bf16x8*)(DF + r32 * AST + (64 * g + 16 * s + 8 * hi) * 2); acc = MFMA32(a, bfr[s], acc); }
        tile_out(acc, pscale, (LAS float*)(L + BL_STG) + wave * 32 * STG_LD, nullptr, gq, Y + (size_t)tok0 * D + 32 * wave, lane);
    }
    __syncthreads();
}

__device__ __forceinline__ void attn_unit(LAS unsigned char* L, const bf16* PROJ, bf16* Y, const MixW& W, int unit, int tid, int lane, int wave) {
    const int n = unit & 63, kvh = (unit >> 6) & 1, b = unit >> 7;
    const int tokq0 = b * SEQ + n * 128;
    LAS unsigned char* KL = L + AT_K; LAS unsigned char* VL = L + AT_V;
    const int r32 = lane & 31, hi = lane >> 5;
    const int hq = kvh * 4 + (wave >> 1);
    {
        v4u kq[4], vq[4];
#pragma unroll
        for (int i = 0; i < 4; ++i) { const int e = tid + 512 * i, j = e >> 3, ch = e & 7;
            kq[i] = (v4u){0u, 0u, 0u, 0u}; vq[i] = kq[i];
            if (n > 0 || j >= 128) { const bf16* pr = PROJ + (size_t)(tokq0 - 128 + j) * DIN + kvh * 64 + ch * 8; kq[i] = *(const GAS v4u*)(pr + C_K); vq[i] = *(const GAS v4u*)(pr + C_V); } }
#pragma unroll
        for (int i = 0; i < 4; ++i) { const int e = tid + 512 * i, j = e >> 3, ch = e & 7;
            *(LAS v4u*)(KL + j * 128 + ((ch ^ (j & 7)) << 4)) = kq[i];
            *(LAS v4u*)(VL + j * 128 + ((ch ^ (((j >> 1) & 1) << 2)) << 4)) = vq[i]; }
    }
    __syncthreads();
    const float slope2 = exp2f(-(float)(hq + 1)) * 1.4426950408889634f, sink2 = W.sinks[hq] * 1.4426950408889634f;
    LAS float* stg = (LAS float*)(L + BL_STG) + wave * 32 * STG_LD;
    LAS float* invl = (LAS float*)(L + BL_INVL) + wave * 32;
#pragma unroll 1
    for (int blk = 0; blk < 2; ++blk) {
        const int i0 = (wave & 1) * 64 + blk * 32, jt0 = i0 >> 5;
        bf16x8 qf[4]; v4u gq[2][2];
        {
            const bf16* qrow = PROJ + (size_t)(tokq0 + i0 + r32) * DIN + C_Q + hq * 64 + 8 * hi;
#pragma unroll
            for (int s = 0; s < 4; ++s) qf[s] = *(const GAS bf16x8*)(qrow + 16 * s);
            const bf16* gate = PROJ + (size_t)(tokq0 + i0) * DIN + C_GATTN + hq * 64;
            gate_load(gq[0], gate, lane); gate_load(gq[1], gate + 32, lane);
        }
        f32x16 p[5];
        float mx = sink2;
        const int tmask = r32 - 4 * hi;
#pragma unroll
        for (int d = 0; d < 5; ++d) {
            const int jt = jt0 + d;
            f32x16 a;
            if ((n > 0) || (jt >= 4)) {
                const float base = -slope2 * (float)(128 + i0 + r32 - 32 * jt - 4 * hi);
#pragma unroll
                for (int reg = 0; reg < 16; ++reg) a[reg] = base + slope2 * (float)((reg & 3) + 8 * (reg >> 2));
                if (d == 0) {
#pragma unroll
                    for (int reg = 0; reg < 16; ++reg) a[reg] = (tmask >= (reg & 3) + 8 * (reg >> 2)) ? -1e30f : a[reg];
                }
                if (d == 4) {
#pragma unroll
                    for (int reg = 0; reg < 16; ++reg) a[reg] = (tmask >= (reg & 3) + 8 * (reg >> 2)) ? a[reg] : -1e30f;
                }
#pragma unroll
                for (int s = 0; s < 4; ++s) { const int key = 32 * jt + r32; const bf16x8 kf = *(const LAS bf16x8*)(KL + key * 128 + (((2 * s + hi) ^ (key & 7)) << 4)); a = MFMA32(kf, qf[s], a); }
            } else {
#pragma unroll
                for (int reg = 0; reg < 16; ++reg) a[reg] = -1e30f;
            }
#pragma unroll
            for (int reg = 0; reg < 16; ++reg) mx = fmaxf(mx, a[reg]);
            p[d] = a;
        }
        mx = fmaxf(mx, __shfl_xor(mx, 32));
        float lsum = 0.f;
#pragma unroll
        for (int d = 0; d < 5; ++d)
#pragma unroll
            for (int reg = 0; reg < 16; ++reg) { const float e = __builtin_amdgcn_exp2f(p[d][reg] - mx); p[d][reg] = e; lsum += e; }
        lsum += __shfl_xor(lsum, 32);
        lsum += __builtin_amdgcn_exp2f(sink2 - mx);
        if (hi == 0) invl[r32] = __builtin_amdgcn_rcpf(lsum);
        f32x16 o0 = {}, o1 = {};
        const int q4 = (lane & 15) >> 2, p4 = lane & 3, g2 = (lane >> 4) & 1;
#pragma unroll
        for (int d = 0; d < 5; ++d) {
            const int jt = jt0 + d;
#pragma unroll
            for (int s = 0; s < 2; ++s) {
                const bf16x8 pa = packP(p[d], s);
                const int keyA = 32 * jt + 16 * s + 4 * hi + q4, keyB = keyA + 8;
                const int offA = keyA * 128 + 32 * g2 + 8 * p4, offB = keyB * 128 + 32 * g2 + 8 * p4;
                const int swA = ((keyA >> 1) & 1) << 6, swB = ((keyB >> 1) & 1) << 6;
                const s16x4 a0 = __builtin_bit_cast(s16x4, __builtin_amdgcn_ds_read_tr16_b64_v4i16((LAS s16x4*)(VL + (offA ^ swA))));
                const s16x4 b0 = __builtin_bit_cast(s16x4, __builtin_amdgcn_ds_read_tr16_b64_v4i16((LAS s16x4*)(VL + (offB ^ swB))));
                const s16x4 a1 = __builtin_bit_cast(s16x4, __builtin_amdgcn_ds_read_tr16_b64_v4i16((LAS s16x4*)(VL + ((offA + 64) ^ swA))));
                const s16x4 b1 = __builtin_bit_cast(s16x4, __builtin_amdgcn_ds_read_tr16_b64_v4i16((LAS s16x4*)(VL + ((offB + 64) ^ swB))));
                const bf16x8 v0 = {a0[0], a0[1], a0[2], a0[3], b0[0], b0[1], b0[2], b0[3]}, v1 = {a1[0], a1[1], a1[2], a1[3], b1[0], b1[1], b1[2], b1[3]};
                o0 = MFMA32(pa, v0, o0); o1 = MFMA32(pa, v1, o1);
            }
        }
        bf16* yp = Y + (size_t)(tokq0 + i0) * D + 512 + hq * 64;
        tile_out(o0, 1.f, stg, invl, gq[0], yp, lane);
        tile_out(o1, 1.f, stg, invl, gq[1], yp + 32, lane);
    }
    __syncthreads();
}
__device__ __forceinline__ float bf2f(bf16 v) { return __uint_as_float((unsigned)v << 16); }
__device__ __forceinline__ float wave_sum(float v) {
#pragma unroll
    for (int o = 1; o < 64; o <<= 1) v += __shfl_xor(v, o);
    return v;
}
__device__ __forceinline__ float silu_f(float x) { return x / (1.f + __expf(-x)); }
__device__ __forceinline__ float sigmoid_f(float x) { return 1.f / (1.f + __expf(-x)); }

__device__ __forceinline__ void p0_transpose_item(const float* W, int K, int N, bf16* WT, LAS float* scr, int item, int lane, const float* kscale) {
    const int nblk = N / 32, kb = item / nblk, nb = item % nblk, k0 = 64 * kb, n0 = 32 * nb;
    const int c = lane & 7;
    f32x4 v[8], ks0 = {1.f, 1.f, 1.f, 1.f}, ks1 = ks0;
#pragma unroll
    for (int i = 0; i < 8; ++i) v[i] = *(const GAS f32x4*)(W + (size_t)(k0 + 8 * i + (lane >> 3)) * N + n0 + 4 * c);
    if (kscale) { ks0 = *(const GAS f32x4*)(kscale + k0 + 8 * c); ks1 = *(const GAS f32x4*)(kscale + k0 + 8 * c + 4); }
#pragma unroll
    for (int i = 0; i < 8; ++i) { LAS float* d = scr + (8 * i + (lane >> 3)) * 33 + 4 * c; d[0] = v[i][0]; d[1] = v[i][1]; d[2] = v[i][2]; d[3] = v[i][3]; }
    LDS_WAIT(); asm volatile("" ::: "memory");
#pragma unroll
    for (int j = 0; j < 4; ++j) { const int n = (lane >> 3) + 8 * j; const LAS float* s = scr + (8 * c) * 33 + n;
        v4u o; o.x = pk2(s[0 * 33] * ks0[0], s[1 * 33] * ks0[1]); o.y = pk2(s[2 * 33] * ks0[2], s[3 * 33] * ks0[3]); o.z = pk2(s[4 * 33] * ks1[0], s[5 * 33] * ks1[1]); o.w = pk2(s[6 * 33] * ks1[2], s[7 * 33] * ks1[3]);
        *(GAS v4u*)(WT + (size_t)(n0 + n) * K + k0 + 8 * c) = o; }
    LDS_WAIT(); asm volatile("" ::: "memory");
}

struct Args { const float* in[13]; float* out; unsigned char* ws; int ph_lo, ph_hi; };

__global__ void __launch_bounds__(NWAVES * 64, 2) fwd(Args args) {
    extern __shared__ __attribute__((aligned(16))) unsigned char lds[];
    LAS unsigned char* L = (LAS unsigned char*)lds;
    volatile LAS unsigned* MISC = (volatile LAS unsigned*)(L + MISC_OFF);
    const int tid = threadIdx.x, lane = tid & 63, wave = __builtin_amdgcn_readfirstlane(tid >> 6);
    const int G = gridDim.x;
    unsigned char* ws = args.ws;
    gu32* ctl = (gu32*)(ws + WS_CTL);
    const float* x = args.in[0]; const float* ln_g = args.in[1]; const float* w_in = args.in[2]; const float* pool_w = args.in[3]; const float* pool_scale = args.in[4];
    const float* conv_dw = args.in[5]; const float* conv_b = args.in[6]; const float* conv_ln_g = args.in[7]; const float* conv_ln_b = args.in[8]; const float* conv_pw = args.in[9];
    const float* attn_sinks = args.in[10]; const float* w_out = args.in[11]; const float* final_g = args.in[12];
    float* out = args.out;
    bf16* WIN = (bf16*)(ws + WS_WIN); bf16* WOUT = (bf16*)(ws + WS_WOUT); bf16* WPW = (bf16*)(ws + WS_WPW); bf16* WPOOL = (bf16*)(ws + WS_WPOOL);
    float* SSP = (float*)(ws + WS_SSP); bf16* XB = (bf16*)(ws + WS_XB); bf16* PROJ = (bf16*)(ws + WS_PROJ); bf16* Y = (bf16*)(ws + WS_Y);
    for (int u = tid; u < (LDS_BYTES - LDSCTL_OFF) / 4; u += NWAVES * 64) ((LAS unsigned*)(L + LDSCTL_OFF))[u] = 0u;
    __syncthreads();
    XcdBarrier bar; bar.bar = (unsigned*)(ctl + CW_BAR); bar.x = 0; bar.st = nullptr;
    if (N_LAUNCHES == 1) bar = xcd_barrier_post((unsigned*)(ctl + CW_BAR), MISC + 8);
    const int lo = args.ph_lo, hi = args.ph_hi;
#define IN(k) (lo <= (k) && (k) < hi)
#define SEAM(k) do { if (IN(k) && IN((k) + 1)) xcd_barrier(bar); } while (0)
#define REPS(k) ((PROBE_DUP == (k)) ? 2 : 1)

    for (int rep = 0; rep < REPS(0); ++rep) { if (rep) xcd_barrier(bar);
    if (IN(0)) {
        LAS float* scr = (LAS float*)(L + RING_OFF + wave * 16384);
        const int gw = blockIdx.x * NWAVES + wave, NGW = G * NWAVES;
        constexpr int I_IN = (D / 64) * (DIN / 32), I_OUT = (D / 64) * (D / 32), I_PW = (256 / 64) * (256 / 32), I_PL = 2;
        constexpr int NITEMS = DEPTH * (I_IN + I_OUT + I_PW + 4 * I_PL);
        for (int it = gw; it < NITEMS; it += NGW) {
            int r = it;
            if (r < DEPTH * I_IN) { const int l = r / I_IN; p0_transpose_item(w_in + (size_t)l * D * DIN, D, DIN, WIN + (size_t)l * DIN * D, scr, r % I_IN, lane, ln_g + l * D); continue; } r -= DEPTH * I_IN;
            if (r < DEPTH * I_OUT) { const int l = r / I_OUT; p0_transpose_item(w_out + (size_t)l * D * D, D, D, WOUT + (size_t)l * D * D, scr, r % I_OUT, lane, nullptr); continue; } r -= DEPTH * I_OUT;
            if (r < DEPTH * I_PW) { const int l = r / I_PW; p0_transpose_item(conv_pw + (size_t)l * 65536, 256, 256, WPW + (size_t)l * 65536, scr, r % I_PW, lane, nullptr); continue; } r -= DEPTH * I_PW;
            { const int lg = r / I_PL; p0_transpose_item(pool_w + (size_t)lg * 4096, 64, 64, WPOOL + (size_t)lg * 4096, scr, r % I_PL, lane, nullptr); }
        }
        for (int m0 = gw; m0 < M; m0 += 4 * NGW) {
            f32x4 v[4][4];
#pragma unroll
            for (int r = 0; r < 4; ++r) { const int m = m0 + r * NGW; if (m < M) { const GAS f32x4* xr = (const GAS f32x4*)(x + (size_t)m * D) + lane;
#pragma unroll
                for (int j = 0; j < 4; ++j) v[r][j] = xr[64 * j]; } }
#pragma unroll
            for (int r = 0; r < 4; ++r) { const int m = m0 + r * NGW; if (m < M) { float s = 0.f;
#pragma unroll
                for (int j = 0; j < 4; ++j) s += (v[r][j].x * v[r][j].x + v[r][j].y * v[r][j].y) + (v[r][j].z * v[r][j].z + v[r][j].w * v[r][j].w);
                s = wave_sum(s);
                GAS unsigned long long* o8 = (GAS unsigned long long*)(XB + (size_t)m * D) + lane;
#pragma unroll
                for (int j = 0; j < 4; ++j) o8[64 * j] = (unsigned long long)pk2(v[r][j].x, v[r][j].y) | ((unsigned long long)pk2(v[r][j].z, v[r][j].w) << 32);
                if (lane == 0) *(f32x4*)(SSP + (size_t)m * 4) = (f32x4){s, 0.f, 0.f, 0.f}; } }
        }
    }
    }
    SEAM(0);
    for (int i = 0; i < PROBE_XBAR; ++i) xcd_barrier(bar);
    for (int l = 0; l < DEPTH; ++l) {
        const int pb = 1 + 3 * l;
        for (int rep = 0; rep < REPS(pb); ++rep) { if (rep) xcd_barrier(bar);
        if (IN(pb)) {
            pg8::Gemm g{XB, WIN + (size_t)l * DIN * D, M, DIN, D}; pg8::StaticOrder S; S.init(M, DIN, G, (int)blockIdx.x);
            pg8::EpiProj E{PROJ, DIN, SSP + (size_t)l * M * 4};
            pg8::gemm_phase<pg8::EpiProj, pg8::StaticOrder, true, true>(L + RING_OFF, g, S, E);
        }
        }
        SEAM(pb);
        for (int rep = 0; rep < REPS(pb + 1); ++rep) { if (rep) xcd_barrier(bar);
        if (IN(pb + 1)) {
            int tid = threadIdx.x; asm volatile("" : "+v"(tid));
            const int lane = tid & 63;
            MixW W{pool_scale + l * 256, conv_dw + l * 31 * 256, conv_b + l * 256, conv_ln_g + l * 256, conv_ln_b + l * 256, attn_sinks + l * 8, WPW + (size_t)l * 65536, WPOOL + (size_t)l * 16384};
            for (int rr = 0; rr < ((PROBE_DUP == 20) ? 2 : 1); ++rr)
            for (int u = blockIdx.x; u < 256; u += G) attn_unit(L, PROJ, Y, W, u, tid, lane, wave);
            for (int rr = 0; rr < ((PROBE_DUP == 21) ? 2 : 1); ++rr)
            for (int u = blockIdx.x; u < 512; u += G) conv_unit(L, PROJ, Y, W, 32 * u, tid, lane, wave);
            for (int rr = 0; rr < ((PROBE_DUP == 22) ? 2 : 1); ++rr)
            for (int u = blockIdx.x; u < 512; u += G) pool_unit(L, PROJ, Y, W, 32 * u, tid, lane, wave);
        }
        }
        SEAM(pb + 1);
        if (IN(pb + 2)) {
            pg8::Gemm g{Y, WOUT + (size_t)l * D * D, M, D, D}; pg8::StaticOrder S; S.init(M, D, G, (int)blockIdx.x);
            pg8::EpiRes E{x, XB, SSP + (size_t)(l + 1) * M * 4, D, l};
            pg8::gemm_phase<pg8::EpiRes, pg8::StaticOrder, false, true>(L + RING_OFF, g, S, E);
        }
        SEAM(pb + 2);
    }
    if (IN(7)) {
        int tid = threadIdx.x; asm volatile("" : "+v"(tid));
        const int lane = tid & 63;
        const int gw = blockIdx.x * NWAVES + wave, NGW = G * NWAVES;
        const float* ssp2 = SSP + (size_t)2 * M * 4;
        f32x4 gg[4];
#pragma unroll
        for (int h = 0; h < 2; ++h) { gg[2 * h] = *(const GAS f32x4*)(final_g + 512 * h + 8 * lane); gg[2 * h + 1] = *(const GAS f32x4*)(final_g + 512 * h + 8 * lane + 4); }
        for (int m0 = gw; m0 < M; m0 += 4 * NGW) {
            v4u xv[4][2]; f32x4 sp[4];
#pragma unroll
            for (int r = 0; r < 4; ++r) { const int m = m0 + r * NGW; if (m < M) { xv[r][0] = *(const GAS v4u*)(XB + (size_t)m * D + 8 * lane); xv[r][1] = *(const GAS v4u*)(XB + (size_t)m * D + 512 + 8 * lane); sp[r] = *(const GAS f32x4*)(ssp2 + (size_t)m * 4); } }
#pragma unroll
            for (int r = 0; r < 4; ++r) { const int m = m0 + r * NGW; if (m < M) {
                const float rs = rsqrtf(((sp[r][0] + sp[r][1]) + (sp[r][2] + sp[r][3])) * (1.f / D) + EPS);
#pragma unroll
                for (int h = 0; h < 2; ++h) { const v4u w = xv[r][h];
                    const f32x4 a = (f32x4){bflo(w.x), bfhi(w.x), bflo(w.y), bfhi(w.y)} * rs * gg[2 * h], b = (f32x4){bflo(w.z), bfhi(w.z), bflo(w.w), bfhi(w.w)} * rs * gg[2 * h + 1];
                    GAS f32x4* o = (GAS f32x4*)(out + (size_t)m * D + 512 * h + 8 * lane); o[0] = a; o[1] = b; } } }
        }
    }
#undef IN
#undef SEAM
}

extern "C" void kernel_launch(void* const* d_in, const int* in_sizes, int n_in, void* d_out, int out_size, void* d_ws, size_t ws_size, hipStream_t stream) {
    static int grid = 0;
    if (grid == 0) {
        if (n_in != 13 || in_sizes[0] != M * D || out_size != M * D || ws_size < WS_END) { fprintf(stderr, "kernel_launch: unexpected shapes (n_in %d in0 %d out %d ws %zu)\n", n_in, n_in > 0 ? in_sizes[0] : -1, out_size, ws_size); grid = -1; return; }
        int dev = 0, cus = 0, per_cu = 0;
        if (hipGetDevice(&dev) != hipSuccess || hipDeviceGetAttribute(&cus, hipDeviceAttributeMultiprocessorCount, dev) != hipSuccess) { grid = -1; return; }
        if (hipFuncSetAttribute((const void*)fwd, hipFuncAttributeMaxDynamicSharedMemorySize, LDS_BYTES) != hipSuccess) { fprintf(stderr, "kernel_launch: hipFuncSetAttribute failed\n"); grid = -1; return; }
        if (hipOccupancyMaxActiveBlocksPerMultiprocessor(&per_cu, (const void*)fwd, NWAVES * 64, LDS_BYTES) != hipSuccess || per_cu < 1) { fprintf(stderr, "kernel_launch: occupancy query says %d blocks/CU\n", per_cu); }
        (void)hipGetLastError();
        if (cus != 256) { fprintf(stderr, "kernel_launch: built for a 256-CU device, found %d\n", cus); grid = -1; return; }
        grid = cus;
    }
    if (grid < 0) return;
    if (hipMemsetAsync((char*)d_ws + WS_CTL, 0, CTL_ZERO_BYTES, stream) != hipSuccess) return;
    Args a{};
    for (int i = 0; i < 13; ++i) a.in[i] = (const float*)d_in[i];
    a.out = (float*)d_out; a.ws = (unsigned char*)d_ws;
    for (int li = 0; li < N_LAUNCHES; ++li) {
        a.ph_lo = (N_LAUNCHES == 1) ? 0 : li; a.ph_hi = (N_LAUNCHES == 1) ? NPH : li + 1;
        hipLaunchKernelGGL(fwd, dim3(grid), dim3(NWAVES * 64), LDS_BYTES, stream, a);
    }
}
```

```cpp
#include <hip/hip_runtime.h>
#include <cstdio>
#include <cstdint>
namespace pg8 {
#define PG8_LAS __attribute__((address_space(3)))
typedef unsigned short bf16_t;
typedef short bf16x8 __attribute__((ext_vector_type(8)));
typedef float f32x4 __attribute__((ext_vector_type(4)));
typedef unsigned u32x4 __attribute__((ext_vector_type(4)));
constexpr int BM = 256, BK = 64, HALF = 128, HTB = HALF * BK * 2  , STAGE_BYTES = 8 * HTB, NXCD = 8, WGM = 8;

__host__ __device__ __forceinline__ int lds_byte(int r, int c) { const int st = (r >> 4) * 2 + (c >> 5), rr = r & 15, cc = c & 31, ob = rr * 64 + cc * 2; return st * 1024 + (ob ^ (((ob >> 9) & 1) << 5)); }
__host__ __device__ __forceinline__ void stage_rc(int b, int& R, int& C) { const int st = b / 1024, sb = b % 1024, swz = sb ^ (((sb >> 9) & 1) << 5); R = (st >> 1) * 16 + swz / 64; C = (st & 1) * 32 + (swz % 64) / 2; }
__host__ __device__ __forceinline__ int perm32(int rho) { const int n = rho >> 4, i = rho & 15; return 8 * (i >> 2) + 4 * n + (i & 3); }

struct Unit { int pm, pn; };
struct Gemm { const bf16_t* A; const bf16_t* Bt; int M, N, K; };

struct StaticOrder {
    int nM, nN, nwg, G, c;
    __host__ __device__ void init(int M, int N, int G_, int c_) { nM = M / BM; nN = N / BM; nwg = nM * nN; G = G_; c = c_; }
    __host__ __device__ bool next(int i, Unit& u) const {
        const long L = (long)i * G + c; if (L >= nwg) return false;
        int wgid = (int)L; { const int q = nwg / NXCD, r = nwg % NXCD, xcd = wgid % NXCD, off = wgid / NXCD; wgid = (xcd < r ? xcd * (q + 1) : r * (q + 1) + (xcd - r) * q) + off; }
        const int nig = WGM * nN, gid = wgid / nig, fm = gid * WGM, gsz = (nM - fm) < WGM ? (nM - fm) : WGM;
        u.pm = fm + ((wgid % nig) % gsz); u.pn = (wgid % nig) / gsz; return true;
    }
    __device__ __forceinline__ void a_ready(const Unit&) const {}
    __device__ __forceinline__ void done(const Unit&) const {}
};

__device__ __forceinline__ unsigned cvt_pk_bf16(float lo, float hi) { unsigned r; asm volatile("v_cvt_pk_bf16_f32 %0, %1, %2" : "=v"(r) : "v"(lo), "v"(hi)); return r; }
typedef float f32x2 __attribute__((ext_vector_type(2)));
typedef unsigned u32x2 __attribute__((ext_vector_type(2)));
struct EpiProj {
    static constexpr bool PERM = true, AFTER_DRAIN = false;
    bf16_t* O; int ldc; const float* ssp;
    __device__ __forceinline__ void operator()(const f32x4 (&acc)[2][2][4][2], const Unit& u, int wr, int wc, int fr, int fq) const {
        const int row0 = u.pm * BM + wr * 64 + fr, col0 = u.pn * BM + wc * 32 + 8 * fq;
        const float qs = (u.pn == 5 || u.pn == 6) ? 0.18033688011112042f : 1.0f;
#pragma unroll
        for (int ai = 0; ai < 2; ++ai)
#pragma unroll
            for (int m = 0; m < 4; ++m) {
                const int row = row0 + ai * HALF + m * 16;
                const f32x4 s = *(const f32x4*)(ssp + (size_t)row * 4);
                const float rs = qs * rsqrtf(((s[0] + s[1]) + (s[2] + s[3])) * (1.0f / 1024.0f) + 1e-6f);
                bf16_t* rowp = O + (size_t)row * ldc + col0;
#pragma unroll
                for (int bj = 0; bj < 2; ++bj) { const f32x4 v0 = acc[ai][bj][m][0] * rs, v1 = acc[ai][bj][m][1] * rs;
                    u32x4 w; w.x = cvt_pk_bf16(v0[0], v0[1]); w.y = cvt_pk_bf16(v0[2], v0[3]); w.z = cvt_pk_bf16(v1[0], v1[1]); w.w = cvt_pk_bf16(v1[2], v1[3]);
                    *(u32x4*)(rowp + bj * HALF) = w; }
            }
    }
};
struct EpiRes {
    static constexpr bool PERM = false, AFTER_DRAIN = true;
    const float* basef; bf16_t* xb; float* ssp; int ldc; int base_bf16;
    __device__ __forceinline__ void fused(f32x4 (&acc)[2][2][4][2], const Unit& u, int wr, int wc, int fr, int fq, PG8_LAS unsigned char* lds, int wid, int lane) const {
        PG8_LAS float* P = (PG8_LAS float*)lds;
        const int col0 = u.pn * BM + wc * 32 + 4 * fq;
#pragma unroll
        for (int ai = 0; ai < 2; ++ai)
#pragma unroll
            for (int m = 0; m < 4; ++m) { const int r = ai * HALF + wr * 64 + m * 16 + fr; const size_t off = (size_t)(u.pm * BM + r) * ldc + col0; float s = 0.f;
                f32x4 bs[2][2];
                if (base_bf16) {
#pragma unroll
                    for (int bj = 0; bj < 2; ++bj)
#pragma unroll
                        for (int n = 0; n < 2; ++n) { const u32x2 w = *(const u32x2*)(xb + off + bj * HALF + n * 16);
                            bs[bj][n] = (f32x4){__uint_as_float(w.x << 16), __uint_as_float(w.x & 0xffff0000u), __uint_as_float(w.y << 16), __uint_as_float(w.y & 0xffff0000u)}; }
                } else {
#pragma unroll
                    for (int bj = 0; bj < 2; ++bj)
#pragma unroll
                        for (int n = 0; n < 2; ++n) bs[bj][n] = *(const f32x4*)(basef + off + bj * HALF + n * 16);
                }
#pragma unroll
                for (int bj = 0; bj < 2; ++bj)
#pragma unroll
                    for (int n = 0; n < 2; ++n) { const f32x4 o = bs[bj][n] + acc[ai][bj][m][n];
                        u32x2 w; w.x = cvt_pk_bf16(o[0], o[1]); w.y = cvt_pk_bf16(o[2], o[3]); *(u32x2*)(xb + off + bj * HALF + n * 16) = w;
                        s += (o[0] * o[0] + o[1] * o[1]) + (o[2] * o[2] + o[3] * o[3]); }
                s += __shfl_xor(s, 16); s += __shfl_xor(s, 32);
                if (fq == 0) P[r * 4 + wc] = s;
                if (m & 1) asm volatile("" ::: "memory"); }
        asm volatile("s_waitcnt lgkmcnt(0)" ::: "memory"); __builtin_amdgcn_s_barrier(); asm volatile("" ::: "memory");
        const int tid = wid * 64 + lane;
        if (tid < 256) { const f32x4 p = *(const PG8_LAS f32x4*)(P + tid * 4); ssp[(size_t)(u.pm * BM + tid) * 4 + u.pn] = (p[0] + p[1]) + (p[2] + p[3]); }
        asm volatile("s_waitcnt lgkmcnt(0)" ::: "memory"); __builtin_amdgcn_s_barrier(); asm volatile("" ::: "memory");
    }
};
template <class Epi, class Sched, bool ALIGN_EPI = false, bool SP2 = false>
__device__ __forceinline__ void gemm_phase(PG8_LAS unsigned char* lds, const Gemm g, const Sched& S, const Epi& E) {
    int tid_ = threadIdx.x; asm volatile("" : "+v"(tid_));
    const int tid = tid_, wid = __builtin_amdgcn_readfirstlane(tid >> 6), lane = tid & 63, wr = wid >> 2, wc = wid & 3, fr = lane & 15, fq = lane >> 4;
    const int K = g.K, nt = K / BK;
    unsigned voffA[2], voffB[2];
#pragma unroll
    for (int i = 0; i < 2; ++i) { int R, C; stage_rc(tid * 16 + i * 8192, R, C); const int Rb = Epi::PERM ? ((R & ~31) + perm32(R & 31)) : R;
        voffA[i] = (unsigned)(R * K + C) * 2u; voffB[i] = (unsigned)(Rb * K + C) * 2u; }
    const size_t kstep = (size_t)(BK * 2);
    const size_t hstep = (size_t)HALF * K * 2;
    const size_t tstep = 2 * hstep;
    const unsigned ldsw = (unsigned)wid * 1024u;
    const int aoff = lds_byte(wr * 64 + fr, fq * 8), boff = lds_byte(wc * 32 + fr, fq * 8);
#define PG8_SA(b, h) (((b) * 2 + (h)) * HTB)
#define PG8_SB(b, h) ((4 + (b) * 2 + (h)) * HTB)
#define PG8_STAGE(bufoff, gbase, voff) do { _Pragma("unroll") for (int _i = 0; _i < 2; ++_i) \
        __builtin_amdgcn_global_load_lds((const unsigned*)((const char*)(gbase) + (voff)[_i]), (PG8_LAS unsigned*)(lds + (bufoff) + ldsw + _i * 8192), 16, 0, 0); } while (0)
#define PG8_LDA(dst, b, h) do { _Pragma("unroll") for (int m = 0; m < 4; ++m) _Pragma("unroll") for (int k = 0; k < 2; ++k) dst[m][k] = *(const PG8_LAS bf16x8*)(lds + PG8_SA(b, h) + aoff + m * 2048 + k * 1024); } while (0)
#define PG8_LDB(dst, b, h) do { _Pragma("unroll") for (int n = 0; n < 2; ++n) _Pragma("unroll") for (int k = 0; k < 2; ++k) dst[n][k] = *(const PG8_LAS bf16x8*)(lds + PG8_SB(b, h) + boff + n * 2048 + k * 1024); } while (0)
#define PG8_MMA(ai, bj, At, Bt) do { __builtin_amdgcn_s_setprio(1); _Pragma("unroll") for (int m = 0; m < 4; ++m) _Pragma("unroll") for (int n = 0; n < 2; ++n) _Pragma("unroll") for (int k = 0; k < 2; ++k) \
        acc[ai][bj][m][n] = __builtin_amdgcn_mfma_f32_16x16x32_bf16(Bt[n][k], At[m][k], acc[ai][bj][m][n], 0, 0, 0); __builtin_amdgcn_s_setprio(0); } while (0)
#define PG8_WAIT_V(n) asm volatile("s_waitcnt vmcnt(" #n ")" ::: "memory")
#define PG8_WAIT_L(n) asm volatile("s_waitcnt lgkmcnt(" #n ")" ::: "memory")
#define PG8_BAR __builtin_amdgcn_s_barrier()
#define PG8_SCHED __builtin_amdgcn_sched_barrier(0)
    Unit cur, nxt; int ui = 0;
    if (!S.next(0, cur)) return;
    f32x4 acc[2][2][4][2];
#pragma unroll
    for (int a = 0; a < 2; ++a)
#pragma unroll
        for (int b = 0; b < 2; ++b)
#pragma unroll
            for (int m = 0; m < 4; ++m)
#pragma unroll
                for (int n = 0; n < 2; ++n) acc[a][b][m][n] = (f32x4){0.f, 0.f, 0.f, 0.f};
    bf16x8 At[4][2], B0[2][2], B1[2][2];
    const char* cA = (const char*)g.A + (size_t)cur.pm * tstep; const char* cB = (const char*)g.Bt + (size_t)cur.pn * tstep;
    S.a_ready(cur);
    if constexpr (SP2) {
        PG8_STAGE(PG8_SB(0, 0), cB, voffB); PG8_STAGE(PG8_SB(0, 1), cB + hstep, voffB); PG8_STAGE(PG8_SA(0, 0), cA, voffA); PG8_STAGE(PG8_SA(0, 1), cA + hstep, voffA);
        if (wr == 1) PG8_BAR;
        PG8_WAIT_V(2); PG8_BAR;
        PG8_STAGE(PG8_SB(1, 0), cB + kstep, voffB); PG8_STAGE(PG8_SA(1, 0), cA + kstep, voffA); PG8_STAGE(PG8_SB(1, 1), cB + hstep + kstep, voffB);
        PG8_WAIT_V(6); PG8_BAR;
    } else {
        PG8_STAGE(PG8_SB(0, 0), cB, voffB); PG8_STAGE(PG8_SA(0, 0), cA, voffA); PG8_STAGE(PG8_SB(0, 1), cB + hstep, voffB); PG8_STAGE(PG8_SA(0, 1), cA + hstep, voffA);
        if (wr == 1) PG8_BAR;
        PG8_WAIT_V(4); PG8_BAR;
        PG8_STAGE(PG8_SB(1, 0), cB + kstep, voffB); PG8_STAGE(PG8_SA(1, 0), cA + kstep, voffA); PG8_STAGE(PG8_SB(1, 1), cB + hstep + kstep, voffB);
        PG8_WAIT_V(6); PG8_BAR;
    }
    for (;;) {
        const bool has_next = S.next(ui + 1, nxt);
        const char* nA = has_next ? (const char*)g.A + (size_t)nxt.pm * tstep : cA; const char* nB = has_next ? (const char*)g.Bt + (size_t)nxt.pn * tstep : cB;
        for (int t = 0; t < nt; t += 2) {
            const bool last = (t == nt - 2);
            const char* a1 = cA + (size_t)(t + 1) * kstep;
            const char* a2 = last ? nA : cA + (size_t)(t + 2) * kstep; const char* b2 = last ? nB : cB + (size_t)(t + 2) * kstep;
            const char* a3 = a2 + kstep; const char* b3 = b2 + kstep;
            if (last && has_next) S.a_ready(nxt);
            if constexpr (SP2) {
            PG8_LDB(B0, 0, 0); PG8_LDB(B1, 0, 1); PG8_SCHED; PG8_LDA(At, 0, 0); PG8_STAGE(PG8_SA(1, 1), a1 + hstep, voffA);
            PG8_WAIT_V(8); PG8_WAIT_L(0); PG8_BAR; PG8_MMA(0, 0, At, B0); PG8_MMA(0, 1, At, B1); PG8_BAR; PG8_SCHED;
            PG8_LDA(At, 0, 1); PG8_STAGE(PG8_SB(0, 0), b2, voffB); PG8_STAGE(PG8_SB(0, 1), b2 + hstep, voffB); PG8_STAGE(PG8_SA(0, 0), a2, voffA);
            PG8_WAIT_V(8); PG8_WAIT_L(0); PG8_BAR; PG8_MMA(1, 0, At, B0); PG8_MMA(1, 1, At, B1); PG8_BAR; PG8_SCHED;
            PG8_LDB(B0, 1, 0); PG8_LDB(B1, 1, 1); PG8_SCHED; PG8_LDA(At, 1, 0); PG8_STAGE(PG8_SA(0, 1), a2 + hstep, voffA);
            PG8_WAIT_V(8); PG8_WAIT_L(0); PG8_BAR; PG8_MMA(0, 0, At, B0); PG8_MMA(0, 1, At, B1); PG8_BAR; PG8_SCHED;
            PG8_LDA(At, 1, 1); PG8_STAGE(PG8_SB(1, 0), b3, voffB); PG8_STAGE(PG8_SB(1, 1), b3 + hstep, voffB); PG8_STAGE(PG8_SA(1, 0), a3, voffA);
            PG8_WAIT_V(8); PG8_WAIT_L(0); PG8_BAR; PG8_MMA(1, 0, At, B0); PG8_MMA(1, 1, At, B1); PG8_BAR; PG8_SCHED;
            } else {
            PG8_LDB(B0, 0, 0); PG8_SCHED; PG8_LDA(At, 0, 0); PG8_STAGE(PG8_SA(1, 1), a1 + hstep, voffA);
            PG8_WAIT_L(8); PG8_BAR; PG8_WAIT_L(0); PG8_MMA(0, 0, At, B0); PG8_BAR; PG8_SCHED;
            PG8_LDB(B1, 0, 1); PG8_STAGE(PG8_SB(0, 0), b2, voffB);
            PG8_BAR; PG8_WAIT_L(0); PG8_MMA(0, 1, At, B1); PG8_BAR;
            PG8_LDA(At, 0, 1); PG8_STAGE(PG8_SA(0, 0), a2, voffA);
            PG8_BAR; PG8_WAIT_L(0); PG8_MMA(1, 0, At, B0); PG8_BAR; PG8_SCHED;
            PG8_STAGE(PG8_SB(0, 1), b2 + hstep, voffB);
            PG8_WAIT_V(6); PG8_BAR; PG8_MMA(1, 1, At, B1); PG8_BAR;
            PG8_LDB(B0, 1, 0); PG8_SCHED; PG8_LDA(At, 1, 0); PG8_STAGE(PG8_SA(0, 1), a2 + hstep, voffA);
            PG8_WAIT_L(8); PG8_BAR; PG8_WAIT_L(0); PG8_MMA(0, 0, At, B0); PG8_BAR; PG8_SCHED;
            PG8_LDB(B1, 1, 1); PG8_STAGE(PG8_SB(1, 0), b3, voffB);
            PG8_BAR; PG8_WAIT_L(0); PG8_MMA(0, 1, At, B1); PG8_BAR;
            PG8_LDA(At, 1, 1); PG8_STAGE(PG8_SA(1, 0), a3, voffA);
            PG8_BAR; PG8_WAIT_L(0); PG8_MMA(1, 0, At, B0); PG8_BAR; PG8_SCHED;
            PG8_STAGE(PG8_SB(1, 1), b3 + hstep, voffB);
            PG8_WAIT_V(6); PG8_BAR; PG8_MMA(1, 1, At, B1); PG8_BAR;
            }
        }
        if constexpr (ALIGN_EPI) { if (wr == 0) PG8_BAR; }
        if constexpr (!Epi::AFTER_DRAIN) { E(acc, cur, wr, wc, fr, fq); S.done(cur); }
        if (!has_next) break;
#pragma unroll
        for (int a = 0; a < 2; ++a)
#pragma unroll
            for (int b = 0; b < 2; ++b)
#pragma unroll
                for (int m = 0; m < 4; ++m)
#pragma unroll
                    for (int n = 0; n < 2; ++n) acc[a][b][m][n] = (f32x4){0.f, 0.f, 0.f, 0.f};
        cur = nxt; cA = nA; cB = nB; ++ui;
        if constexpr (ALIGN_EPI) { if (wr == 1) PG8_BAR; }
    }
    PG8_WAIT_V(0);
    if constexpr (!ALIGN_EPI) { if (wr == 0) PG8_BAR; }
    PG8_BAR;
    if constexpr (Epi::AFTER_DRAIN) { E.fused(acc, cur, wr, wc, fr, fq, lds, wid, lane); S.done(cur); }
#undef PG8_SA
#undef PG8_SB
#undef PG8_STAGE
#undef PG8_LDA
#undef PG8_LDB
#undef PG8_MMA
#undef PG8_WAIT_V
#undef PG8_WAIT_L
#undef PG8_BAR
#undef PG8_SCHED
}
}
constexpr int NWAVES = 8;
#ifndef MK_N_LAUNCHES
#define MK_N_LAUNCHES 1
#endif
#ifndef PROBE_DUP
#define PROBE_DUP -1
#endif
#ifndef PROBE_XBAR
#define PROBE_XBAR 0
#endif
constexpr int N_LAUNCHES = MK_N_LAUNCHES;
constexpr int NPH = 8;
constexpr int D = 1024, BATCH = 2, SEQ = 8192, M = BATCH * SEQ, DIN = 2560, DEPTH = 2;
constexpr int C_UPOOL = 0, C_GPOOL = 256, C_CA = 512, C_CB = 768, C_GCONV = 1024, C_Q = 1280, C_K = 1792, C_V = 1920, C_GATTN = 2048;
constexpr float EPS = 1e-6f;
constexpr size_t MiB = 1u << 20;
constexpr size_t WS_CTL = 0, CTL_ZERO_BYTES = 1 * MiB;
constexpr size_t WS_WIN = 2 * MiB;
constexpr size_t WS_WOUT = 12 * MiB;
constexpr size_t WS_WPW = 16 * MiB;
constexpr size_t WS_WPOOL = 16 * MiB + 512 * 1024;
constexpr size_t WS_SSP = 17 * MiB;
constexpr size_t WS_XB = 32 * MiB;
constexpr size_t WS_PROJ = 64 * MiB;
constexpr size_t WS_Y = 144 * MiB;
constexpr size_t WS_END = 176 * MiB;
constexpr int CW_BAR = 4096;
constexpr int RING_OFF = 0, RING_BYTES = 131072, LDSCTL_OFF = 146432, MISC_OFF = LDSCTL_OFF + 320, LDS_BYTES = 147456;
#define GAS __attribute__((address_space(1)))
#define LAS __attribute__((address_space(3)))
typedef unsigned short bf16;
typedef unsigned v4u __attribute__((ext_vector_type(4)));
typedef float f32x4 __attribute__((ext_vector_type(4)));
typedef short bf16x8 __attribute__((ext_vector_type(8)));
typedef GAS unsigned gu32;
typedef GAS unsigned long long gu64;
#define RLX_AGENT __ATOMIC_RELAXED, __HIP_MEMORY_SCOPE_AGENT
#define LDS_WAIT() asm volatile("s_waitcnt lgkmcnt(0)" ::: "memory")
#define VM_WAIT() asm volatile("s_waitcnt vmcnt(0)" ::: "memory")
__device__ __forceinline__ unsigned long long rt() { return __builtin_amdgcn_s_memrealtime(); }
__device__ __forceinline__ unsigned f2bf(float f) { unsigned u = __builtin_bit_cast(unsigned, f); return (u + 0x7fffu + ((u >> 16) & 1u)) >> 16; }
__device__ __forceinline__ unsigned pk2(float lo, float hi) { return f2bf(lo) | (f2bf(hi) << 16); }
#define XB_TMO      128
#define XB_XCNT(j)  (256  + 64 * (j))
#define XB_XSUB(j)  (1280 + 64 * (j))
#define XB_XGEN(j)  (2304 + 64 * (j))
#define XB_TOP      3328
#define XB_TOPGEN   3392
#define XCD_BAR_WORDS 3456
#define XB_SPIN_CAP (1u << 18)

__device__ __forceinline__ unsigned xb_ld(unsigned* p)              { return __hip_atomic_load(p, __ATOMIC_RELAXED, __HIP_MEMORY_SCOPE_AGENT); }
__device__ __forceinline__ unsigned xb_add(unsigned* p, unsigned v) { return __hip_atomic_fetch_add(p, v, __ATOMIC_RELAXED, __HIP_MEMORY_SCOPE_AGENT); }
__device__ __forceinline__ unsigned xb_xcc_id() { return (unsigned)__builtin_amdgcn_s_getreg((3 << 11) | 20) & 0xFu; }
#define XB_SPIN(cond, bar) do { unsigned _sp = 0; while (cond) { __builtin_amdgcn_s_sleep(1); \
    if ((++_sp & 255u) == 0u) { if (xb_ld(&(bar)[XB_TMO])) break; if (_sp > XB_SPIN_CAP) { atomicAdd(&(bar)[XB_TMO], 1u); break; } } } } while (0)

struct XcdBarrier {
    unsigned* bar; unsigned x;
    volatile LAS unsigned* st;
};

__device__ __forceinline__ XcdBarrier xcd_barrier_post(unsigned* bar, volatile LAS unsigned* st) {
    XcdBarrier b; b.bar = bar; b.x = xb_xcc_id(); b.st = st;
    if (threadIdx.x == 0) (void)xb_add(&bar[XB_XCNT(b.x)], 1u);
    return b;
}
__device__ __forceinline__ void xcd_barrier_complete(unsigned* bar, unsigned x, unsigned& nloc, unsigned& nx) {
    const unsigned G = gridDim.x * gridDim.y * gridDim.z;
    unsigned sum, cnt, mine, sp = 0u;
    for (;;) {
        sum = 0u; cnt = 0u; mine = 0u;
#pragma unroll
        for (unsigned j = 0; j < 16; ++j) { const unsigned c = xb_ld(&bar[XB_XCNT(j)]); sum += c; cnt += (c > 0u) ? 1u : 0u; mine = (j == x) ? c : mine; }
        if (sum == G) break;
        __builtin_amdgcn_s_sleep(1);
        if ((++sp & 255u) == 0u) { if (xb_ld(&bar[XB_TMO])) break; if (sp > XB_SPIN_CAP) { atomicAdd(&bar[XB_TMO], 1u); break; } }
    }
    nloc = mine > 0u ? mine : 1u; nx = cnt > 0u ? cnt : 1u;
}

__device__ __forceinline__ void xcd_barrier(const XcdBarrier& b) {
    asm volatile("s_waitcnt vmcnt(0)" ::: "memory");
    __syncthreads();
    if (threadIdx.x == 0) {
        unsigned* bar = b.bar;
        __builtin_amdgcn_s_waitcnt(0);
        unsigned nloc = b.st[0], nx = b.st[1];
        if (nloc == 0u) { xcd_barrier_complete(bar, b.x, nloc, nx); b.st[0] = nloc; b.st[1] = nx; }
        const unsigned old = xb_add(&bar[XB_XSUB(b.x)], 1u);
        const unsigned gen = old / nloc;
        if (old + 1u == (gen + 1u) * nloc) {
            __builtin_amdgcn_fence(__ATOMIC_RELEASE, "agent");
            asm volatile("s_waitcnt vmcnt(0)" ::: "memory");
            const unsigned og = xb_add(&bar[XB_TOP], 1u);
            const unsigned tg = og / nx;
            if (og + 1u == (tg + 1u) * nx) xb_add(&bar[XB_TOPGEN], 1u);
            else XB_SPIN(xb_ld(&bar[XB_TOPGEN]) == tg, bar);
            __builtin_amdgcn_fence(__ATOMIC_ACQUIRE, "agent");
            xb_add(&bar[XB_XGEN(b.x)], 1u);
            asm volatile("s_waitcnt vmcnt(0)" ::: "memory");
        } else {
            XB_SPIN(xb_ld(&bar[XB_XGEN(b.x)]) == gen, bar);
            __builtin_amdgcn_fence(__ATOMIC_ACQUIRE, "agent");
            asm volatile("s_waitcnt vmcnt(0)" ::: "memory");
        }
    }
    __syncthreads();
}
typedef float f32x16 __attribute__((ext_vector_type(16)));
typedef short s16x4 __attribute__((ext_vector_type(4)));
typedef float f32x2_t __attribute__((ext_vector_type(2)));
typedef __bf16 bf16x2_t __attribute__((ext_vector_type(2)));
#define MFMA32(a, b, c) __builtin_amdgcn_mfma_f32_32x32x16_bf16((a), (b), (c), 0, 0, 0)
__device__ __forceinline__ int crow(int r, int hi) { return (r & 3) + 8 * (r >> 2) + 4 * hi; }
__device__ __forceinline__ unsigned cvtpk(float lo, float hi) { f32x2_t v = {lo, hi}; bf16x2_t b = __builtin_convertvector(v, bf16x2_t); return __builtin_bit_cast(unsigned, b); }
__device__ __forceinline__ float bflo(unsigned w) { return __uint_as_float(w << 16); }
__device__ __forceinline__ float bfhi(unsigned w) { return __uint_as_float(w & 0xffff0000u); }
__device__ __forceinline__ float fsilu(float x) { return x * __builtin_amdgcn_rcpf(1.f + __builtin_amdgcn_exp2f(-1.4426950408889634f * x)); }
__device__ __forceinline__ float fsigm(float x) { return __builtin_amdgcn_rcpf(1.f + __builtin_amdgcn_exp2f(-1.4426950408889634f * x)); }
__device__ __forceinline__ bf16x8 packP(const f32x16& p, int s) {
    v4u w; w.x = cvtpk(p[8 * s], p[8 * s + 1]); w.y = cvtpk(p[8 * s + 2], p[8 * s + 3]); w.z = cvtpk(p[8 * s + 4], p[8 * s + 5]); w.w = cvtpk(p[8 * s + 6], p[8 * s + 7]);
    return __builtin_bit_cast(bf16x8, w);
}
constexpr int STG_LD = 36;
constexpr int BL_STG = 0, BL_INVL = 8 * 32 * STG_LD * 4, BL_R1 = BL_INVL + 1024;
constexpr int AST = 528;
constexpr int CV_GLU = BL_R1, CV_HN = BL_R1, CV_OUT = BL_R1 + 62 * 1024;
constexpr int PL_U = BL_R1, PL_DIFF = BL_R1 + 47 * 1024;
constexpr int AT_K = BL_R1, AT_V = BL_R1 + 32768;
static_assert(CV_OUT + 32768 <= 146432 && PL_DIFF + 32 * AST <= 146432 && AT_V + 32768 <= 146432, "mixer LDS map");

__device__ __forceinline__ void gate_load(v4u (&gq)[2], const bf16* gate, int lane) {
#pragma unroll
    for (int it = 0; it < 2; ++it) { const int idx = it * 64 + lane, row = idx >> 2, c8 = (idx & 3) * 8; gq[it] = *(const GAS v4u*)(gate + (size_t)row * DIN + c8); }
}
__device__ __forceinline__ void tile_out(const f32x16& acc, float colscale, LAS float* stg, const LAS float* rowscale, const v4u (&gq)[2], bf16* yp, int lane) {
    const int r32 = lane & 31, hi = lane >> 5;
#pragma unroll
    for (int reg = 0; reg < 16; ++reg) stg[crow(reg, hi) * STG_LD + r32] = acc[reg] * colscale;
    f32x4 sv[2][2]; float rsv[2] = {1.f, 1.f};
#pragma unroll
    for (int it = 0; it < 2; ++it) { const int idx = it * 64 + lane, row = idx >> 2, c8 = (idx & 3) * 8;
        sv[it][0] = *(const LAS f32x4*)(stg + row * STG_LD + c8); sv[it][1] = *(const LAS f32x4*)(stg + row * STG_LD + c8 + 4); if (rowscale) rsv[it] = rowscale[row]; }
#pragma unroll
    for (int it = 0; it < 2; ++it) {
        const int idx = it * 64 + lane, row = idx >> 2, c8 = (idx & 3) * 8;
        const f32x4 v0 = sv[it][0] * rsv[it], v1 = sv[it][1] * rsv[it];
        v4u o;
        o.x = cvtpk(v0[0] * fsilu(bflo(gq[it].x)), v0[1] * fsilu(bfhi(gq[it].x)));
        o.y = cvtpk(v0[2] * fsilu(bflo(gq[it].y)), v0[3] * fsilu(bfhi(gq[it].y)));
        o.z = cvtpk(v1[0] * fsilu(bflo(gq[it].z)), v1[1] * fsilu(bfhi(gq[it].z)));
        o.w = cvtpk(v1[2] * fsilu(bflo(gq[it].w)), v1[3] * fsilu(bfhi(gq[it].w)));
        *(GAS v4u*)(yp + (size_t)row * D + c8) = o;
    }
}

struct MixW { const float *pool_scale, *dw, *cb, *lg, *lb, *sinks; const bf16 *wpw, *wpool; };

__device__ __forceinline__ void conv_unit(LAS unsigned char* L, const bf16* PROJ, bf16* Y, const MixW& W, int tok0, int tid, int lane, int wave) {
    LAS float* GLU = (LAS float*)(L + CV_GLU); LAS float* CO = (LAS float*)(L + CV_OUT); LAS unsigned char* HN = L + CV_HN;
    const int t0 = tok0 & (SEQ - 1);
    v4u gq[2]; gate_load(gq, PROJ + (size_t)tok0 * DIN + C_GCONV + 32 * wave, lane);
    float w[31];
#pragma unroll
    for (int j = 0; j < 31; ++j) w[j] = W.dw[j * 256 + (tid & 255)];
    const float bias = W.cb[tid & 255];
    {
        v4u av[4], bv[4];
#pragma unroll
        for (int i = 0; i < 4; ++i) { const int e = tid + 512 * i, r = e >> 5, c8 = (e & 31) * 8;
            av[i] = (v4u){0u, 0u, 0u, 0u}; bv[i] = av[i];
            if (e < 62 * 32 && t0 - 30 + r >= 0) { const bf16* pr = PROJ + (size_t)(tok0 - 30 + r) * DIN; av[i] = *(const GAS v4u*)(pr + C_CA + c8); bv[i] = *(const GAS v4u*)(pr + C_CB + c8); } }
#pragma unroll
        for (int i = 0; i < 4; ++i) { const int e = tid + 512 * i, r = e >> 5, c8 = (e & 31) * 8;
            if (e < 62 * 32) { const v4u a = av[i], b = bv[i]; f32x4 g0, g1;
                g0[0] = bflo(a.x) * fsigm(bflo(b.x)); g0[1] = bfhi(a.x) * fsigm(bfhi(b.x)); g0[2] = bflo(a.y) * fsigm(bflo(b.y)); g0[3] = bfhi(a.y) * fsigm(bfhi(b.y));
                g1[0] = bflo(a.z) * fsigm(bflo(b.z)); g1[1] = bfhi(a.z) * fsigm(bfhi(b.z)); g1[2] = bflo(a.w) * fsigm(bflo(b.w)); g1[3] = bfhi(a.w) * fsigm(bfhi(b.w));
                *(LAS f32x4*)(GLU + r * 256 + c8) = g0; *(LAS f32x4*)(GLU + r * 256 + c8 + 4) = g1; } }
    }
    __syncthreads();
    const int tk = tid >> 4, part = tid & 15;
    f32x4 lgv[4], lbv[4];
#pragma unroll
    for (int i = 0; i < 4; ++i) { const int c = 64 * i + 4 * part; lgv[i] = *(const GAS f32x4*)(W.lg + c); lbv[i] = *(const GAS f32x4*)(W.lb + c); }
    {
        const int c = tid & 255, th = tid >> 8;
#pragma unroll
        for (int grp = 0; grp < 2; ++grp) {
            const int o0 = 16 * th + 8 * grp;
            float in[38];
#pragma unroll
            for (int k = 0; k < 38; ++k) in[k] = GLU[(o0 + k) * 256 + c];
#pragma unroll
            for (int o = 0; o < 8; ++o) { float a = bias;
#pragma unroll
                for (int j = 0; j < 31; ++j) a += w[j] * in[o + j];
                CO[(o0 + o) * 256 + c] = a; }
        }
    }
    __syncthreads();
    const int r32 = lane & 31, hi = lane >> 5;
    bf16x8 bfr[16];
    {
        const bf16* wrow = W.wpw + (size_t)(32 * wave + r32) * 256 + 8 * hi;
#pragma unroll
        for (int s = 0; s < 16; ++s) bfr[s] = *(const GAS bf16x8*)(wrow + 16 * s);
    }
    {
        f32x4 v[4]; float s = 0.f;
#pragma unroll
        for (int i = 0; i < 4; ++i) { v[i] = *(const LAS f32x4*)(CO + tk * 256 + 64 * i + 4 * part); s += (v[i][0] + v[i][1]) + (v[i][2] + v[i][3]); }
        s += __shfl_xor(s, 1); s += __shfl_xor(s, 2); s += __shfl_xor(s, 4); s += __shfl_xor(s, 8);
        const float mu = s * (1.f / 256.f); float q = 0.f;
#pragma unroll
        for (int i = 0; i < 4; ++i) { v[i] = v[i] - mu; q += (v[i][0] * v[i][0] + v[i][1] * v[i][1]) + (v[i][2] * v[i][2] + v[i][3] * v[i][3]); }
        q += __shfl_xor(q, 1); q += __shfl_xor(q, 2); q += __shfl_xor(q, 4); q += __shfl_xor(q, 8);
        const float rstd = rsqrtf(q * (1.f / 256.f) + EPS);
#pragma unroll
        for (int i = 0; i < 4; ++i) { const int c = 64 * i + 4 * part;
            const f32x4 y = v[i] * rstd * lgv[i] + lbv[i];
            pg8::u32x2 o; o.x = cvtpk(fsilu(y[0]), fsilu(y[1])); o.y = cvtpk(fsilu(y[2]), fsilu(y[3]));
            *(LAS pg8::u32x2*)(HN + tk * AST + c * 2) = o; }
    }
    __syncthreads();
    {
        f32x16 acc = {};
        bf16x8 af[16];
#pragma unroll
        for (int s = 0; s < 16; ++s) af[s] = *(const LAS bf16x8*)(HN + r32 * AST + (16 * s + 8 * hi) * 2);
#pragma unroll
        for (int s = 0; s < 16; ++s) acc = MFMA32(af[s], bfr[s], acc);
        tile_out(acc, 1.f, (LAS float*)(L + BL_STG) + wave * 32 * STG_LD, nullptr, gq, Y + (size_t)tok0 * D + 256 + 32 * wave, lane);
    }
    __syncthreads();
}

__device__ __forceinline__ void pool_unit(LAS unsigned char* L, const bf16* PROJ, bf16* Y, const MixW& W, int tok0, int tid, int lane, int wave) {
    LAS float* U = (LAS float*)(L + PL_U); LAS unsigned char* DF = L + PL_DIFF;
    const int t0 = tok0 & (SEQ - 1);
    v4u gq[2]; gate_load(gq, PROJ + (size_t)tok0 * DIN + C_GPOOL + 32 * wave, lane);
    bf16x8 bfr[4];
    { const bf16* wrow = W.wpool + (size_t)(wave >> 1) * 4096 + (size_t)(32 * (wave & 1) + (lane & 31)) * 64 + 8 * (lane >> 5);
#pragma unroll
      for (int s = 0; s < 4; ++s) bfr[s] = *(const GAS bf16x8*)(wrow + 16 * s); }
    const float pscale = W.pool_scale[32 * wave + (lane & 31)];
    {
        v4u av[3];
#pragma unroll
        for (int i = 0; i < 3; ++i) { const int e = tid + 512 * i, r = e >> 5, c8 = (e & 31) * 8;
            av[i] = (v4u){0u, 0u, 0u, 0u};
            if (e < 47 * 32 && t0 - 15 + r >= 0) av[i] = *(const GAS v4u*)(PROJ + (size_t)(tok0 - 15 + r) * DIN + C_UPOOL + c8); }
#pragma unroll
        for (int i = 0; i < 3; ++i) { const int e = tid + 512 * i, r = e >> 5, c8 = (e & 31) * 8;
            if (e < 47 * 32) { const v4u a = av[i]; f32x4 g0, g1;
                g0[0] = bflo(a.x); g0[1] = bfhi(a.x); g0[2] = bflo(a.y); g0[3] = bfhi(a.y); g1[0] = bflo(a.z); g1[1] = bfhi(a.z); g1[2] = bflo(a.w); g1[3] = bfhi(a.w);
                *(LAS f32x4*)(U + r * 256 + c8) = g0; *(LAS f32x4*)(U + r * 256 + c8 + 4) = g1; } }
    }
    __syncthreads();
    {
        const int c = tid & 255, th = tid >> 8, g = wave & 3, wnd = 2 << g;
        const int R0 = 16 * th + 15;
        float s = 0.f;
        for (int k = 0; k < wnd; ++k) s += U[(R0 - k) * 256 + c];
#pragma unroll 4
        for (int o = 0; o < 16; ++o) {
            const int tp = t0 + 16 * th + o; const int cnt = (tp + 1 < wnd) ? tp + 1 : wnd;
            const float uv = U[(R0 + o) * 256 + c];
            const float df = s * __builtin_amdgcn_rcpf((float)cnt) - uv;
            *(LAS bf16*)(DF + (16 * th + o) * AST + c * 2) = (bf16)(cvtpk(df, 0.f) & 0xffffu);
            if (o < 15) s += U[(R0 + o + 1) * 256 + c] - U[(R0 + o + 1 - wnd) * 256 + c];
        }
    }
    __syncthreads();
    {
        const int r32 = lane & 31, hi = lane >> 5, g = wave >> 1;
        f32x16 acc = {};
        bf16x8 af[4];
#pragma unroll
        for (int s = 0; s < 4; ++s) af[s] = *(const LAS bf16x8*)(DF + r32 * AST + (64 * g + 16 * s + 8 * hi) * 2);
#pragma unroll
        for (int s = 0; s < 4; ++s) acc = MFMA32(af[s], bfr[s], acc);
        tile_out(acc, pscale, (LAS float*)(L + BL_STG) + wave * 32 * STG_LD, nullptr, gq, Y + (size_t)tok0 * D + 32 * wave, lane);
    }
    __syncthreads();
}

__device__ __forceinline__ void attn_unit(LAS unsigned char* L, const bf16* PROJ, bf16* Y, const MixW& W, int unit, int tid, int lane, int wave) {
    const int n = unit & 63, kvh = (unit >> 6) & 1, b = unit >> 7;
    const int tokq0 = b * SEQ + n * 128;
    LAS unsigned char* KL = L + AT_K; LAS unsigned char* VL = L + AT_V;
    const int r32 = lane & 31, hi = lane >> 5;
    const int hq = kvh * 4 + (wave >> 1);
    bf16x8 qn[4];
    {
        const int i0 = (wave & 1) * 64;
        const bf16* qrow = PROJ + (size_t)(tokq0 + i0 + r32) * DIN + C_Q + hq * 64 + 8 * hi;
#pragma unroll
        for (int s = 0; s < 4; ++s) qn[s] = *(const GAS bf16x8*)(qrow + 16 * s);
    }
    {
        v4u kq[4], vq[4];
#pragma unroll
        for (int i = 0; i < 4; ++i) { const int e = tid + 512 * i, j = e >> 3, ch = e & 7;
            kq[i] = (v4u){0u, 0u, 0u, 0u}; vq[i] = kq[i];
            if (n > 0 || j >= 128) { const bf16* pr = PROJ + (size_t)(tokq0 - 128 + j) * DIN + kvh * 64 + ch * 8; kq[i] = *(const GAS v4u*)(pr + C_K); vq[i] = *(const GAS v4u*)(pr + C_V); } }
#pragma unroll
        for (int i = 0; i < 4; ++i) { const int e = tid + 512 * i, j = e >> 3, ch = e & 7;
            *(LAS v4u*)(KL + j * 128 + ((ch ^ (j & 7)) << 4)) = kq[i];
            *(LAS v4u*)(VL + j * 128 + ((ch ^ (((j >> 1) & 1) << 2)) << 4)) = vq[i]; }
    }
    __syncthreads();
    const float slope2 = exp2f(-(float)(hq + 1)) * 1.4426950408889634f, sink2 = W.sinks[hq] * 1.4426950408889634f;
    LAS float* stg = (LAS float*)(L + BL_STG) + wave * 32 * STG_LD;
    LAS float* invl = (LAS float*)(L + BL_INVL) + wave * 32;
#pragma unroll 1
    for (int blk = 0; blk < 2; ++blk) {
        const int i0 = (wave & 1) * 64 + blk * 32, jt0 = i0 >> 5;
        bf16x8 qf[4]; v4u gq[2][2];
#pragma unroll
        for (int s = 0; s < 4; ++s) qf[s] = qn[s];
        if (blk == 0) {
            const bf16* qrow = PROJ + (size_t)(tokq0 + i0 + 32 + r32) * DIN + C_Q + hq * 64 + 8 * hi;
#pragma unroll
            for (int s = 0; s < 4; ++s) qn[s] = *(const GAS bf16x8*)(qrow + 16 * s);
        }
        f32x16 p[5];
        float mx = sink2;
        const int tmask = r32 - 4 * hi;
        const LAS unsigned char* kb0 = KL + (32 * jt0 + r32) * 128;
        const int kx = r32 & 7;
        bf16x8 kf[2][4];
#pragma unroll
        for (int s = 0; s < 4; ++s) kf[0][s] = *(const LAS bf16x8*)(kb0 + (((2 * s + hi) ^ kx) << 4));
#pragma unroll
        for (int d = 0; d < 5; ++d) {
            const int jt = jt0 + d;
            if (d < 4) {
#pragma unroll
                for (int s = 0; s < 4; ++s) kf[(d + 1) & 1][s] = *(const LAS bf16x8*)(kb0 + (d + 1) * 4096 + (((2 * s + hi) ^ kx) << 4));
            }
            const bool tile_ok = (n > 0) || (jt >= 4);
            const float base = -slope2 * (float)(128 + i0 + r32 - 32 * jt - 4 * hi);
            f32x16 a;
#pragma unroll
            for (int reg = 0; reg < 16; ++reg) a[reg] = base + slope2 * (float)((reg & 3) + 8 * (reg >> 2));
            if (d == 0) {
#pragma unroll
                for (int reg = 0; reg < 16; ++reg) a[reg] = (tmask >= (reg & 3) + 8 * (reg >> 2)) ? -1e30f : a[reg];
            }
            if (d == 4) {
#pragma unroll
                for (int reg = 0; reg < 16; ++reg) a[reg] = (tmask >= (reg & 3) + 8 * (reg >> 2)) ? a[reg] : -1e30f;
            }
            if (d < 4) {
#pragma unroll
                for (int reg = 0; reg < 16; ++reg) a[reg] = tile_ok ? a[reg] : -1e30f;
            }
#pragma unroll
            for (int s = 0; s < 4; ++s) a = MFMA32(kf[d & 1][s], qf[s], a);
#pragma unroll
            for (int reg = 0; reg < 16; ++reg) mx = fmaxf(mx, a[reg]);
            p[d] = a;
        }
        { const bf16* gate = PROJ + (size_t)(tokq0 + i0) * DIN + C_GATTN + hq * 64; gate_load(gq[0], gate, lane); gate_load(gq[1], gate + 32, lane); }
        mx = fmaxf(mx, __shfl_xor(mx, 32));
        float lsum = 0.f;
#pragma unroll
        for (int d = 0; d < 5; ++d)
#pragma unroll
            for (int reg = 0; reg < 16; ++reg) { const float e = __builtin_amdgcn_exp2f(p[d][reg] - mx); p[d][reg] = e; lsum += e; }
        lsum += __shfl_xor(lsum, 32);
        lsum += __builtin_amdgcn_exp2f(sink2 - mx);
        if (hi == 0) invl[r32] = __builtin_amdgcn_rcpf(lsum);
        f32x16 o0 = {}, o1 = {};
        const int q4 = (lane & 15) >> 2, p4 = lane & 3, g2 = (lane >> 4) & 1;
        const int vsw = ((q4 >> 1) & 1) << 6;
        const LAS unsigned char* vb0 = VL + (32 * jt0 + 4 * hi + q4) * 128 + ((32 * g2 + 8 * p4) ^ vsw);
        const LAS unsigned char* vb1 = VL + (32 * jt0 + 4 * hi + q4) * 128 + ((64 + 32 * g2 + 8 * p4) ^ vsw);
#define VTR(ptr) __builtin_bit_cast(s16x4, __builtin_amdgcn_ds_read_tr16_b64_v4i16((LAS s16x4*)(ptr)))
        s16x4 va[2][4];
        va[0][0] = VTR(vb0); va[0][1] = VTR(vb0 + 1024); va[0][2] = VTR(vb1); va[0][3] = VTR(vb1 + 1024);
#pragma unroll
        for (int st = 0; st < 10; ++st) {
            if (st < 9) { const int o = (st + 1) * 2048;
                va[(st + 1) & 1][0] = VTR(vb0 + o); va[(st + 1) & 1][1] = VTR(vb0 + o + 1024); va[(st + 1) & 1][2] = VTR(vb1 + o); va[(st + 1) & 1][3] = VTR(vb1 + o + 1024); }
            const bf16x8 pa = packP(p[st >> 1], st & 1);
            const s16x4 a0 = va[st & 1][0], b0 = va[st & 1][1], a1 = va[st & 1][2], b1 = va[st & 1][3];
            const bf16x8 v0 = {a0[0], a0[1], a0[2], a0[3], b0[0], b0[1], b0[2], b0[3]}, v1 = {a1[0], a1[1], a1[2], a1[3], b1[0], b1[1], b1[2], b1[3]};
            o0 = MFMA32(pa, v0, o0); o1 = MFMA32(pa, v1, o1);
        }
#undef VTR
        bf16* yp = Y + (size_t)(tokq0 + i0) * D + 512 + hq * 64;
        tile_out(o0, 1.f, stg, invl, gq[0], yp, lane);
        tile_out(o1, 1.f, stg, invl, gq[1], yp + 32, lane);
    }
    __syncthreads();
}
__device__ __forceinline__ float bf2f(bf16 v) { return __uint_as_float((unsigned)v << 16); }
__device__ __forceinline__ float wave_sum(float v) {
#pragma unroll
    for (int o = 1; o < 64; o <<= 1) v += __shfl_xor(v, o);
    return v;
}
__device__ __forceinline__ float silu_f(float x) { return x / (1.f + __expf(-x)); }
__device__ __forceinline__ float sigmoid_f(float x) { return 1.f / (1.f + __expf(-x)); }

__device__ __forceinline__ void p0_transpose_item(const float* W, int K, int N, bf16* WT, LAS float* scr, int item, int lane, const float* kscale) {
    const int nblk = N / 32, kb = item / nblk, nb = item % nblk, k0 = 64 * kb, n0 = 32 * nb;
    const int c = lane & 7;
    f32x4 v[8], ks0 = {1.f, 1.f, 1.f, 1.f}, ks1 = ks0;
#pragma unroll
    for (int i = 0; i < 8; ++i) v[i] = *(const GAS f32x4*)(W + (size_t)(k0 + 8 * i + (lane >> 3)) * N + n0 + 4 * c);
    if (kscale) { ks0 = *(const GAS f32x4*)(kscale + k0 + 8 * c); ks1 = *(const GAS f32x4*)(kscale + k0 + 8 * c + 4); }
#pragma unroll
    for (int i = 0; i < 8; ++i) { LAS float* d = scr + (8 * i + (lane >> 3)) * 33 + 4 * c; d[0] = v[i][0]; d[1] = v[i][1]; d[2] = v[i][2]; d[3] = v[i][3]; }
    LDS_WAIT(); asm volatile("" ::: "memory");
#pragma unroll
    for (int j = 0; j < 4; ++j) { const int n = (lane >> 3) + 8 * j; const LAS float* s = scr + (8 * c) * 33 + n;
        v4u o; o.x = pk2(s[0 * 33] * ks0[0], s[1 * 33] * ks0[1]); o.y = pk2(s[2 * 33] * ks0[2], s[3 * 33] * ks0[3]); o.z = pk2(s[4 * 33] * ks1[0], s[5 * 33] * ks1[1]); o.w = pk2(s[6 * 33] * ks1[2], s[7 * 33] * ks1[3]);
        *(GAS v4u*)(WT + (size_t)(n0 + n) * K + k0 + 8 * c) = o; }
    LDS_WAIT(); asm volatile("" ::: "memory");
}

struct Args { const float* in[13]; float* out; unsigned char* ws; int ph_lo, ph_hi; };

__global__ void __launch_bounds__(NWAVES * 64, 2) fwd(Args args) {
    extern __shared__ __attribute__((aligned(16))) unsigned char lds[];
    LAS unsigned char* L = (LAS unsigned char*)lds;
    volatile LAS unsigned* MISC = (volatile LAS unsigned*)(L + MISC_OFF);
    const int tid = threadIdx.x, lane = tid & 63, wave = __builtin_amdgcn_readfirstlane(tid >> 6);
    const int G = gridDim.x;
    unsigned char* ws = args.ws;
    gu32* ctl = (gu32*)(ws + WS_CTL);
    const float* x = args.in[0]; const float* ln_g = args.in[1]; const float* w_in = args.in[2]; const float* pool_w = args.in[3]; const float* pool_scale = args.in[4];
    const float* conv_dw = args.in[5]; const float* conv_b = args.in[6]; const float* conv_ln_g = args.in[7]; const float* conv_ln_b = args.in[8]; const float* conv_pw = args.in[9];
    const float* attn_sinks = args.in[10]; const float* w_out = args.in[11]; const float* final_g = args.in[12];
    float* out = args.out;
    bf16* WIN = (bf16*)(ws + WS_WIN); bf16* WOUT = (bf16*)(ws + WS_WOUT); bf16* WPW = (bf16*)(ws + WS_WPW); bf16* WPOOL = (bf16*)(ws + WS_WPOOL);
    float* SSP = (float*)(ws + WS_SSP); bf16* XB = (bf16*)(ws + WS_XB); bf16* PROJ = (bf16*)(ws + WS_PROJ); bf16* Y = (bf16*)(ws + WS_Y);
    for (int u = tid; u < (LDS_BYTES - LDSCTL_OFF) / 4; u += NWAVES * 64) ((LAS unsigned*)(L + LDSCTL_OFF))[u] = 0u;
    __syncthreads();
    XcdBarrier bar; bar.bar = (unsigned*)(ctl + CW_BAR); bar.x = 0; bar.st = nullptr;
    if (N_LAUNCHES == 1) bar = xcd_barrier_post((unsigned*)(ctl + CW_BAR), MISC + 8);
    const int lo = args.ph_lo, hi = args.ph_hi;
#define IN(k) (lo <= (k) && (k) < hi)
#define SEAM(k) do { if (IN(k) && IN((k) + 1)) xcd_barrier(bar); } while (0)
#define REPS(k) ((PROBE_DUP == (k)) ? 2 : 1)

    for (int rep = 0; rep < REPS(0); ++rep) { if (rep) xcd_barrier(bar);
    if (IN(0)) {
        LAS float* scr = (LAS float*)(L + RING_OFF + wave * 16384);
        const int gw = blockIdx.x * NWAVES + wave, NGW = G * NWAVES;
        constexpr int I_IN = (D / 64) * (DIN / 32), I_OUT = (D / 64) * (D / 32), I_PW = (256 / 64) * (256 / 32), I_PL = 2;
        constexpr int NITEMS = DEPTH * (I_IN + I_OUT + I_PW + 4 * I_PL);
        for (int it = gw; it < NITEMS; it += NGW) {
            int r = it;
            if (r < DEPTH * I_IN) { const int l = r / I_IN; p0_transpose_item(w_in + (size_t)l * D * DIN, D, DIN, WIN + (size_t)l * DIN * D, scr, r % I_IN, lane, ln_g + l * D); continue; } r -= DEPTH * I_IN;
            if (r < DEPTH * I_OUT) { const int l = r / I_OUT; p0_transpose_item(w_out + (size_t)l * D * D, D, D, WOUT + (size_t)l * D * D, scr, r % I_OUT, lane, nullptr); continue; } r -= DEPTH * I_OUT;
            if (r < DEPTH * I_PW) { const int l = r / I_PW; p0_transpose_item(conv_pw + (size_t)l * 65536, 256, 256, WPW + (size_t)l * 65536, scr, r % I_PW, lane, nullptr); continue; } r -= DEPTH * I_PW;
            { const int lg = r / I_PL; p0_transpose_item(pool_w + (size_t)lg * 4096, 64, 64, WPOOL + (size_t)lg * 4096, scr, r % I_PL, lane, nullptr); }
        }
        for (int m0 = gw; m0 < M; m0 += 4 * NGW) {
            f32x4 v[4][4];
#pragma unroll
            for (int r = 0; r < 4; ++r) { const int m = m0 + r * NGW; if (m < M) { const GAS f32x4* xr = (const GAS f32x4*)(x + (size_t)m * D) + lane;
#pragma unroll
                for (int j = 0; j < 4; ++j) v[r][j] = xr[64 * j]; } }
#pragma unroll
            for (int r = 0; r < 4; ++r) { const int m = m0 + r * NGW; if (m < M) { float s = 0.f;
#pragma unroll
                for (int j = 0; j < 4; ++j) s += (v[r][j].x * v[r][j].x + v[r][j].y * v[r][j].y) + (v[r][j].z * v[r][j].z + v[r][j].w * v[r][j].w);
                s = wave_sum(s);
                GAS unsigned long long* o8 = (GAS unsigned long long*)(XB + (size_t)m * D) + lane;
#pragma unroll
                for (int j = 0; j < 4; ++j) o8[64 * j] = (unsigned long long)pk2(v[r][j].x, v[r][j].y) | ((unsigned long long)pk2(v[r][j].z, v[r][j].w) << 32);
                if (lane == 0) *(f32x4*)(SSP + (size_t)m * 4) = (f32x4){s, 0.f, 0.f, 0.f}; } }
        }
    }
    }
    SEAM(0);
    for (int i = 0; i < PROBE_XBAR; ++i) xcd_barrier(bar);
    for (int l = 0; l < DEPTH; ++l) {
        const int pb = 1 + 3 * l;
        for (int rep = 0; rep < REPS(pb); ++rep) { if (rep) xcd_barrier(bar);
        if (IN(pb)) {
            pg8::Gemm g{XB, WIN + (size_t)l * DIN * D, M, DIN, D}; pg8::StaticOrder S; S.init(M, DIN, G, (int)blockIdx.x);
            pg8::EpiProj E{PROJ, DIN, SSP + (size_t)l * M * 4};
            pg8::gemm_phase<pg8::EpiProj, pg8::StaticOrder, true, true>(L + RING_OFF, g, S, E);
        }
        }
        SEAM(pb);
        for (int rep = 0; rep < REPS(pb + 1); ++rep) { if (rep) xcd_barrier(bar);
        if (IN(pb + 1)) {
            int tid = threadIdx.x; asm volatile("" : "+v"(tid));
            const int lane = tid & 63;
            MixW W{pool_scale + l * 256, conv_dw + l * 31 * 256, conv_b + l * 256, conv_ln_g + l * 256, conv_ln_b + l * 256, attn_sinks + l * 8, WPW + (size_t)l * 65536, WPOOL + (size_t)l * 16384};
            for (int rr = 0; rr < ((PROBE_DUP == 20) ? 2 : 1); ++rr)
            for (int u = blockIdx.x; u < 256; u += G) attn_unit(L, PROJ, Y, W, u, tid, lane, wave);
            for (int rr = 0; rr < ((PROBE_DUP == 21) ? 2 : 1); ++rr)
            for (int u = blockIdx.x; u < 512; u += G) conv_unit(L, PROJ, Y, W, 32 * u, tid, lane, wave);
            for (int rr = 0; rr < ((PROBE_DUP == 22) ? 2 : 1); ++rr)
            for (int u = blockIdx.x; u < 512; u += G) pool_unit(L, PROJ, Y, W, 32 * u, tid, lane, wave);
        }
        }
        SEAM(pb + 1);
        if (IN(pb + 2)) {
            pg8::Gemm g{Y, WOUT + (size_t)l * D * D, M, D, D}; pg8::StaticOrder S; S.init(M, D, G, (int)blockIdx.x);
            pg8::EpiRes E{x, XB, SSP + (size_t)(l + 1) * M * 4, D, l};
            pg8::gemm_phase<pg8::EpiRes, pg8::StaticOrder, false, true>(L + RING_OFF, g, S, E);
        }
        SEAM(pb + 2);
    }
    if (IN(7)) {
        int tid = threadIdx.x; asm volatile("" : "+v"(tid));
        const int lane = tid & 63;
        const int gw = blockIdx.x * NWAVES + wave, NGW = G * NWAVES;
        const float* ssp2 = SSP + (size_t)2 * M * 4;
        f32x4 gg[4];
#pragma unroll
        for (int h = 0; h < 2; ++h) { gg[2 * h] = *(const GAS f32x4*)(final_g + 512 * h + 8 * lane); gg[2 * h + 1] = *(const GAS f32x4*)(final_g + 512 * h + 8 * lane + 4); }
        for (int m0 = gw; m0 < M; m0 += 4 * NGW) {
            v4u xv[4][2]; f32x4 sp[4];
#pragma unroll
            for (int r = 0; r < 4; ++r) { const int m = m0 + r * NGW; if (m < M) { xv[r][0] = *(const GAS v4u*)(XB + (size_t)m * D + 8 * lane); xv[r][1] = *(const GAS v4u*)(XB + (size_t)m * D + 512 + 8 * lane); sp[r] = *(const GAS f32x4*)(ssp2 + (size_t)m * 4); } }
#pragma unroll
            for (int r = 0; r < 4; ++r) { const int m = m0 + r * NGW; if (m < M) {
                const float rs = rsqrtf(((sp[r][0] + sp[r][1]) + (sp[r][2] + sp[r][3])) * (1.f / D) + EPS);
#pragma unroll
                for (int h = 0; h < 2; ++h) { const v4u w = xv[r][h];
                    const f32x4 a = (f32x4){bflo(w.x), bfhi(w.x), bflo(w.y), bfhi(w.y)} * rs * gg[2 * h], b = (f32x4){bflo(w.z), bfhi(w.z), bflo(w.w), bfhi(w.w)} * rs * gg[2 * h + 1];
                    GAS f32x4* o = (GAS f32x4*)(out + (size_t)m * D + 512 * h + 8 * lane); o[0] = a; o[1] = b; } } }
        }
    }
#undef IN
#undef SEAM
}

extern "C" void kernel_launch(void* const* d_in, const int* in_sizes, int n_in, void* d_out, int out_size, void* d_ws, size_t ws_size, hipStream_t stream) {
    static int grid = 0;
    if (grid == 0) {
        if (n_in != 13 || in_sizes[0] != M * D || out_size != M * D || ws_size < WS_END) { fprintf(stderr, "kernel_launch: unexpected shapes (n_in %d in0 %d out %d ws %zu)\n", n_in, n_in > 0 ? in_sizes[0] : -1, out_size, ws_size); grid = -1; return; }
        int dev = 0, cus = 0, per_cu = 0;
        if (hipGetDevice(&dev) != hipSuccess || hipDeviceGetAttribute(&cus, hipDeviceAttributeMultiprocessorCount, dev) != hipSuccess) { grid = -1; return; }
        if (hipFuncSetAttribute((const void*)fwd, hipFuncAttributeMaxDynamicSharedMemorySize, LDS_BYTES) != hipSuccess) { fprintf(stderr, "kernel_launch: hipFuncSetAttribute failed\n"); grid = -1; return; }
        if (hipOccupancyMaxActiveBlocksPerMultiprocessor(&per_cu, (const void*)fwd, NWAVES * 64, LDS_BYTES) != hipSuccess || per_cu < 1) { fprintf(stderr, "kernel_launch: occupancy query says %d blocks/CU\n", per_cu); }
        (void)hipGetLastError();
        if (cus != 256) { fprintf(stderr, "kernel_launch: built for a 256-CU device, found %d\n", cus); grid = -1; return; }
        grid = cus;
    }
    if (grid < 0) return;
    if (hipMemsetAsync((char*)d_ws + WS_CTL, 0, CTL_ZERO_BYTES, stream) != hipSuccess) return;
    Args a{};
    for (int i = 0; i < 13; ++i) a.in[i] = (const float*)d_in[i];
    a.out = (float*)d_out; a.ws = (unsigned char*)d_ws;
    for (int li = 0; li < N_LAUNCHES; ++li) {
        a.ph_lo = (N_LAUNCHES == 1) ? 0 : li; a.ph_hi = (N_LAUNCHES == 1) ? NPH : li + 1;
        hipLaunchKernelGGL(fwd, dim3(grid), dim3(NWAVES * 64), LDS_BYTES, stream, a);
    }
}
```
